# Optimizing an MI355X kernel written in HIP

```python
import math
import jax, jax.numpy as jnp
from jax import lax
import numpy as np

D_MODEL = 1024
BATCH = 2
SEQ = 8192
DEPTH = 2

N_MIXERS = 2
N_EVEN = (DEPTH + 1) // 2
N_ODD = DEPTH // 2
ALPHA = (2.0 * DEPTH) ** 0.25
BETA_INIT = (8.0 * DEPTH) ** -0.25
LN_EPS = 1e-5

GDN_K_HEADS = 4
GDN_V_HEADS = 8
GDN_HEAD_K = 128
GDN_HEAD_V = 128
GDN_KDIM = GDN_K_HEADS * GDN_HEAD_K
GDN_VDIM = GDN_V_HEADS * GDN_HEAD_V
GDN_CONV = 4
GDN_CHUNK = 64
GDN_QKV = 2 * GDN_KDIM + GDN_VDIM
GDN_IN = GDN_QKV + GDN_VDIM + 2 * GDN_V_HEADS
GDN_EPS = 1e-6

SWA_Q_HEADS = 16
SWA_KV_HEADS = 2
SWA_GROUP = SWA_Q_HEADS // SWA_KV_HEADS
SWA_HEAD_DIM = 64
SWA_WINDOW = 128
SWA_BLOCK = 128
SWA_QDIM = SWA_Q_HEADS * SWA_HEAD_DIM
SWA_KVDIM = SWA_KV_HEADS * SWA_HEAD_DIM
SWA_IN = SWA_QDIM + 2 * SWA_KVDIM

REL_BUCKETS = 32
REL_MAX_DIST = 128

FFN_DIM = 2816
N_EXPERTS = 8
TOP_K = 2
EXPERT_DIM = 3584

kernel_name = 'hybrid_gdn_swa_moe_deepnorm'


def layer_norm(x, g, b):
    xf = x.astype(jnp.float32)
    mu = jnp.mean(xf, axis=-1, keepdims=True)
    var = jnp.mean(jnp.square(xf - mu), axis=-1, keepdims=True)
    return ((xf - mu) * lax.rsqrt(var + LN_EPS) * g.astype(jnp.float32) + b.astype(jnp.float32)).astype(x.dtype)


def l2_normalize(x):
    xf = x.astype(jnp.float32)
    return xf * lax.rsqrt(jnp.sum(xf * xf, axis=-1, keepdims=True) + GDN_EPS)


def causal_depthwise_conv(x, w):
    width = w.shape[0]
    return lax.conv_general_dilated(
        x, w[:, None, :].astype(x.dtype), window_strides=(1,), padding=[(width - 1, 0)],
        dimension_numbers=('NWC', 'WIO', 'NWC'), feature_group_count=x.shape[-1])


def gated_delta_rule_chunked(q, k, v, g, beta):
    bsz, t, h, dk = q.shape
    dv = v.shape[-1]
    c = GDN_CHUNK
    n = t // c
    f32 = jnp.float32

    def blocks(a):
        a = a.astype(f32).reshape((bsz, n, c, h) + a.shape[3:])
        return jnp.moveaxis(a, 2, 3)

    q, k, v, g, beta = blocks(q), blocks(k), blocks(v), blocks(g), blocks(beta)
    g_cum = jnp.cumsum(g, axis=-1)
    causal = jnp.tril(jnp.ones((c, c), dtype=bool))
    strict = jnp.tril(jnp.ones((c, c), dtype=bool), -1)
    diff = g_cum[..., :, None] - g_cum[..., None, :]
    decay = jnp.exp(jnp.where(causal, diff, -jnp.inf))
    k_beta = k * beta[..., None]
    v_beta = v * beta[..., None]
    a_kk = jnp.where(strict, jnp.einsum('bnhid,bnhjd->bnhij', k_beta, k) * decay, 0.0)
    eye = jnp.eye(c, dtype=f32)
    t_inv = lax.linalg.triangular_solve(eye + a_kk, jnp.broadcast_to(eye, a_kk.shape),
                                        left_side=True, lower=True, unit_diagonal=True)
    u = jnp.einsum('bnhij,bnhje->bnhie', t_inv, v_beta)
    w = jnp.einsum('bnhij,bnhjd->bnhid', t_inv, k_beta * jnp.exp(g_cum)[..., None])
    a_qk = jnp.einsum('bnhid,bnhjd->bnhij', q, k) * decay
    g_last = g_cum[..., -1]
    q_dec = q * jnp.exp(g_cum)[..., None]
    k_dec = k * jnp.exp(g_last[..., None] - g_cum)[..., None]
    xs = (jnp.moveaxis(q_dec, 1, 0), jnp.moveaxis(k_dec, 1, 0), jnp.moveaxis(u, 1, 0),
          jnp.moveaxis(w, 1, 0), jnp.moveaxis(a_qk, 1, 0), jnp.moveaxis(jnp.exp(g_last), 1, 0))

    def step(s, inp):
        qd, kd, uc, wc, aqk, dl = inp
        v_new = uc - jnp.einsum('bhcd,bhde->bhce', wc, s)
        o = jnp.einsum('bhcd,bhde->bhce', qd, s) + jnp.einsum('bhcs,bhse->bhce', aqk, v_new)
        s = s * dl[..., None, None] + jnp.einsum('bhcd,bhce->bhde', kd, v_new)
        return s, o

    s0 = jnp.zeros((bsz, h, dk, dv), f32)
    _, o = lax.scan(step, s0, xs)
    o = jnp.moveaxis(o, 0, 1)
    return jnp.moveaxis(o, 2, 3).reshape(bsz, t, h, dv)


def gated_deltanet(x, w_in, conv_w, a_log, dt_bias, norm_w, w_out):
    bsz, t, _ = x.shape
    proj = x @ w_in
    o1 = GDN_QKV
    o2 = o1 + GDN_VDIM
    o3 = o2 + GDN_V_HEADS
    qkv = jax.nn.silu(causal_depthwise_conv(proj[..., :o1], conv_w))
    z = proj[..., o1:o2].reshape(bsz, t, GDN_V_HEADS, GDN_HEAD_V)
    b_logit = proj[..., o2:o3]
    a_logit = proj[..., o3:]
    q = qkv[..., :GDN_KDIM].reshape(bsz, t, GDN_K_HEADS, GDN_HEAD_K)
    k = qkv[..., GDN_KDIM:2 * GDN_KDIM].reshape(bsz, t, GDN_K_HEADS, GDN_HEAD_K)
    v = qkv[..., 2 * GDN_KDIM:].reshape(bsz, t, GDN_V_HEADS, GDN_HEAD_V)
    rep = GDN_V_HEADS // GDN_K_HEADS
    q = jnp.repeat(l2_normalize(q) * (GDN_HEAD_K ** -0.5), rep, axis=2)
    k = jnp.repeat(l2_normalize(k), rep, axis=2)
    beta = jax.nn.sigmoid(b_logit.astype(jnp.float32))
    g = -jnp.exp(a_log.astype(jnp.float32)) * jax.nn.softplus(
        a_logit.astype(jnp.float32) + dt_bias.astype(jnp.float32))
    o = gated_delta_rule_chunked(q, k, v, g, beta)
    o = o * lax.rsqrt(jnp.mean(o * o, axis=-1, keepdims=True) + GDN_EPS) * norm_w.astype(jnp.float32)
    o = o * jax.nn.silu(z.astype(jnp.float32))
    return o.reshape(bsz, t, GDN_VDIM).astype(x.dtype) @ w_out


def t5_bucket(dist):
    max_exact = REL_BUCKETS // 2
    df = jnp.maximum(dist, 1).astype(jnp.float32)
    large = max_exact + (jnp.log(df / max_exact) / math.log(REL_MAX_DIST / max_exact)
                         * (REL_BUCKETS - max_exact)).astype(jnp.int32)
    large = jnp.minimum(large, REL_BUCKETS - 1)
    return jnp.where(dist < max_exact, dist, large)


def swa_sink_attention(x, w_in, b_in, sinks, rel_bias, w_out):
    bsz, t, _ = x.shape
    nb = t // SWA_BLOCK
    proj = x @ w_in + b_in
    q = proj[..., :SWA_QDIM].reshape(bsz, nb, SWA_BLOCK, SWA_KV_HEADS, SWA_GROUP, SWA_HEAD_DIM)
    k = proj[..., SWA_QDIM:SWA_QDIM + SWA_KVDIM]
    v = proj[..., SWA_QDIM + SWA_KVDIM:]

    def band(a):
        ab = a.reshape(bsz, nb, SWA_BLOCK, SWA_KV_HEADS, SWA_HEAD_DIM)
        prev = jnp.pad(ab, ((0, 0), (1, 0), (0, 0), (0, 0), (0, 0)))[:, :-1]
        return jnp.concatenate([prev, ab], axis=2)

    kb, vb = band(k), band(v)
    s = jnp.einsum('bnqkgd,bnskd->bnkgqs', q, kb).astype(jnp.float32) * (SWA_HEAD_DIM ** -0.5)
    qi = jnp.arange(SWA_BLOCK)[:, None]
    kj = jnp.arange(2 * SWA_BLOCK)[None, :]
    dist = qi + SWA_BLOCK - kj
    bias = rel_bias.astype(jnp.float32)[t5_bucket(jnp.maximum(dist, 0))]
    bias = jnp.transpose(bias, (2, 0, 1)).reshape(SWA_KV_HEADS, SWA_GROUP, SWA_BLOCK, 2 * SWA_BLOCK)
    band_ok = (dist >= 0) & (dist < SWA_WINDOW)
    blk = jnp.arange(nb)[:, None, None]
    mask = band_ok[None] & ((blk > 0) | (kj >= SWA_BLOCK)[None])
    s = jnp.where(mask[None, :, None, None], s + bias, -jnp.inf)
    sink = jnp.broadcast_to(sinks.astype(jnp.float32).reshape(SWA_KV_HEADS, SWA_GROUP, 1, 1),
                            s.shape[:-1] + (1,))
    p = jax.nn.softmax(jnp.concatenate([s, sink], axis=-1), axis=-1)[..., :-1]
    o = jnp.einsum('bnkgqs,bnskd->bnqkgd', p.astype(vb.dtype), vb).reshape(bsz, t, SWA_QDIM)
    return o @ w_out


def swiglu(x, w_gate, w_up, w_down):
    return (jax.nn.silu(x @ w_gate) * (x @ w_up)) @ w_down


def moe_swiglu(x, w_router, w_gate, w_up, w_down):
    bsz, t, d = x.shape
    xf = x.reshape(bsz * t, d)
    logits = (xf @ w_router).astype(jnp.float32)
    top_val, top_idx = lax.top_k(logits, TOP_K)
    top_w = jax.nn.softmax(top_val, axis=-1)
    gates = jnp.einsum('nk,nke->ne', top_w, jax.nn.one_hot(top_idx, N_EXPERTS, dtype=jnp.float32))
    out = jnp.zeros_like(xf)
    for e in range(N_EXPERTS):
        h = jax.nn.silu(xf @ w_gate[e]) * (xf @ w_up[e])
        out = out + gates[:, e:e + 1].astype(xf.dtype) * (h @ w_down[e])
    return out.reshape(bsz, t, d)


def setup_inputs(seed: int = 0) -> dict:
    key = jax.random.key(seed)
    ks = jax.random.split(key, 24)

    def nrm(k, shape, scale):
        return jax.random.normal(k, shape, jnp.float32) * scale

    x = nrm(ks[0], (BATCH, SEQ, D_MODEL), 1.0)
    a_w_in = nrm(ks[1], (N_EVEN, D_MODEL, GDN_IN), D_MODEL ** -0.5)
    a_conv_w = nrm(ks[2], (N_EVEN, GDN_CONV, GDN_QKV), GDN_CONV ** -0.5)
    a_a_log = jnp.log(jax.random.uniform(ks[3], (N_EVEN, GDN_V_HEADS), jnp.float32, 1.0, 16.0))
    dt = jnp.exp(jax.random.uniform(ks[4], (N_EVEN, GDN_V_HEADS), jnp.float32,
                                    math.log(1e-3), math.log(1e-1)))
    a_dt_bias = dt + jnp.log(-jnp.expm1(-dt))
    a_norm_w = 1.0 + nrm(ks[5], (N_EVEN, GDN_HEAD_V), 0.02)
    a_w_out = nrm(ks[6], (N_EVEN, GDN_VDIM, D_MODEL), GDN_VDIM ** -0.5 * BETA_INIT)
    b_w_in = nrm(ks[7], (N_ODD, D_MODEL, SWA_IN), D_MODEL ** -0.5)
    b_b_in = nrm(ks[8], (N_ODD, SWA_IN), 0.02)
    b_sinks = nrm(ks[9], (N_ODD, SWA_Q_HEADS), 1.0)
    b_w_out = nrm(ks[10], (N_ODD, SWA_QDIM, D_MODEL), SWA_QDIM ** -0.5 * BETA_INIT)
    rel_bias = nrm(ks[11], (REL_BUCKETS, SWA_Q_HEADS), 0.3)
    ffn_w_gate = nrm(ks[12], (N_EVEN, D_MODEL, FFN_DIM), D_MODEL ** -0.5)
    ffn_w_up = nrm(ks[13], (N_EVEN, D_MODEL, FFN_DIM), D_MODEL ** -0.5)
    ffn_w_down = nrm(ks[14], (N_EVEN, FFN_DIM, D_MODEL), FFN_DIM ** -0.5 * BETA_INIT)
    moe_router = nrm(ks[15], (N_ODD, D_MODEL, N_EXPERTS), D_MODEL ** -0.5)
    moe_w_gate = nrm(ks[16], (N_ODD, N_EXPERTS, D_MODEL, EXPERT_DIM), D_MODEL ** -0.5)
    moe_w_up = nrm(ks[17], (N_ODD, N_EXPERTS, D_MODEL, EXPERT_DIM), D_MODEL ** -0.5)
    moe_w_down = nrm(ks[18], (N_ODD, N_EXPERTS, EXPERT_DIM, D_MODEL), EXPERT_DIM ** -0.5 * BETA_INIT)
    ln_g = 1.0 + nrm(ks[19], (DEPTH, 2, D_MODEL), 0.02)
    ln_b = nrm(ks[20], (DEPTH, 2, D_MODEL), 0.02)
    return {'x': x, 'a_w_in': a_w_in, 'a_conv_w': a_conv_w, 'a_a_log': a_a_log, 'a_dt_bias': a_dt_bias,
            'a_norm_w': a_norm_w, 'a_w_out': a_w_out, 'b_w_in': b_w_in, 'b_b_in': b_b_in,
            'b_sinks': b_sinks, 'b_w_out': b_w_out, 'rel_bias': rel_bias, 'ffn_w_gate': ffn_w_gate,
            'ffn_w_up': ffn_w_up, 'ffn_w_down': ffn_w_down, 'moe_router': moe_router,
            'moe_w_gate': moe_w_gate, 'moe_w_up': moe_w_up, 'moe_w_down': moe_w_down,
            'ln_g': ln_g, 'ln_b': ln_b}


def reference(x, a_w_in, a_conv_w, a_a_log, a_dt_bias, a_norm_w, a_w_out, b_w_in, b_b_in, b_sinks,
              b_w_out, rel_bias, ffn_w_gate, ffn_w_up, ffn_w_down, moe_router, moe_w_gate, moe_w_up,
              moe_w_down, ln_g, ln_b):
    for i in range(DEPTH):
        j = i // N_MIXERS
        if i % N_MIXERS == 0:
            h = gated_deltanet(x, a_w_in[j], a_conv_w[j], a_a_log[j], a_dt_bias[j], a_norm_w[j], a_w_out[j])
        else:
            h = swa_sink_attention(x, b_w_in[j], b_b_in[j], b_sinks[j], rel_bias, b_w_out[j])
        x = layer_norm(ALPHA * x + h, ln_g[i, 0], ln_b[i, 0])
        if i % 2 == 0:
            f = swiglu(x, ffn_w_gate[j], ffn_w_up[j], ffn_w_down[j])
        else:
            f = moe_swiglu(x, moe_router[j], moe_w_gate[j], moe_w_up[j], moe_w_down[j])
        x = layer_norm(ALPHA * x + f, ln_g[i, 1], ln_b[i, 1])
    return x
```

```cpp
#include <hip/hip_runtime.h>
#include <cstdio>
#include <cstdint>
namespace pg8 {
#define PG8_LAS __attribute__((address_space(3)))
typedef unsigned short bf16_t;
typedef short bf16x8 __attribute__((ext_vector_type(8)));
typedef float f32x4 __attribute__((ext_vector_type(4)));
typedef unsigned u32x4 __attribute__((ext_vector_type(4)));
constexpr int BM = 256, BK = 64, HALF = 128, HTB = HALF * BK * 2  , STAGE_BYTES = 8 * HTB, NXCD = 8, WGM = 8;

__host__ __device__ __forceinline__ int lds_byte(int r, int c) { const int st = (r >> 4) * 2 + (c >> 5), rr = r & 15, cc = c & 31, ob = rr * 64 + cc * 2; return st * 1024 + (ob ^ (((ob >> 9) & 1) << 5)); }
__host__ __device__ __forceinline__ void stage_rc(int b, int& R, int& C) { const int st = b / 1024, sb = b % 1024, swz = sb ^ (((sb >> 9) & 1) << 5); R = (st >> 1) * 16 + swz / 64; C = (st & 1) * 32 + (swz % 64) / 2; }
__host__ __device__ __forceinline__ int perm32(int rho) { const int n = rho >> 4, i = rho & 15; return 8 * (i >> 2) + 4 * n + (i & 3); }

struct Unit { int pm, pn; };
struct Gemm { const bf16_t* A; const bf16_t* Bt; int M, N, K; };

struct StaticOrder {
    int nM, nN, nwg, G, c;
    __host__ __device__ void init(int M, int N, int G_, int c_) { nM = M / BM; nN = N / BM; nwg = nM * nN; G = G_; c = c_; }
    __host__ __device__ bool next(int i, Unit& u) const {
        const long L = (long)i * G + c; if (L >= nwg) return false;
        int wgid = (int)L; { const int q = nwg / NXCD, r = nwg % NXCD, xcd = wgid % NXCD, off = wgid / NXCD; wgid = (xcd < r ? xcd * (q + 1) : r * (q + 1) + (xcd - r) * q) + off; }
        const int nig = WGM * nN, gid = wgid / nig, fm = gid * WGM, gsz = (nM - fm) < WGM ? (nM - fm) : WGM;
        u.pm = fm + ((wgid % nig) % gsz); u.pn = (wgid % nig) / gsz; return true;
    }
    __device__ __forceinline__ void a_ready(const Unit&) const {}
    __device__ __forceinline__ void done(const Unit&) const {}
};

__device__ __forceinline__ unsigned cvt_pk_bf16(float lo, float hi) { unsigned r; asm volatile("v_cvt_pk_bf16_f32 %0, %1, %2" : "=v"(r) : "v"(lo), "v"(hi)); return r; }
typedef float f32x2 __attribute__((ext_vector_type(2)));
template <int ACT  > struct EpiBf16 {
    static constexpr bool PERM = true, AFTER_DRAIN = false; static_assert(ACT == 0, "EpiBf16: ACT is 0");
    bf16_t* O; int ldc; const float* bias; int split_cols; size_t split_stride; float scale0;
    __device__ __forceinline__ void operator()(const f32x4 (&acc)[2][2][4][2], const Unit& u, int wr, int wc, int fr, int fq) const {
        const int row0 = u.pm * BM + wr * 64 + fr; int colt = u.pn * BM; bf16_t* base = O;
        float sc = 1.f; if (split_cols) { const int t = colt / split_cols; base += (size_t)t * split_stride; colt -= t * split_cols; if (t == 0) sc = scale0; }
        const int col0 = colt + wc * 32 + 8 * fq, bcol0 = u.pn * BM + wc * 32 + 8 * fq;
        f32x4 bv[2][2];
#pragma unroll
        for (int bj = 0; bj < 2; ++bj)
#pragma unroll
            for (int n = 0; n < 2; ++n) bv[bj][n] = bias ? *(const f32x4*)(bias + bcol0 + bj * HALF + 4 * n) : (f32x4){0.f, 0.f, 0.f, 0.f};
#pragma unroll
        for (int ai = 0; ai < 2; ++ai)
#pragma unroll
            for (int m = 0; m < 4; ++m) { bf16_t* rowp = base + (size_t)(row0 + ai * HALF + m * 16) * ldc + col0;
#pragma unroll
                for (int bj = 0; bj < 2; ++bj) { f32x4 v0 = acc[ai][bj][m][0] + bv[bj][0], v1 = acc[ai][bj][m][1] + bv[bj][1];
                    v0 = v0 * sc; v1 = v1 * sc; u32x4 w; w.x = cvt_pk_bf16(v0[0], v0[1]); w.y = cvt_pk_bf16(v0[2], v0[3]); w.z = cvt_pk_bf16(v1[0], v1[1]); w.w = cvt_pk_bf16(v1[2], v1[3]);
                    *(u32x4*)(rowp + bj * HALF) = w; } }
    }
};
__device__ __forceinline__ float fast_silu(float x) { return x * __builtin_amdgcn_rcpf(1.0f + __builtin_amdgcn_exp2f(-1.4426950408889634f * x)); }
struct EpiResF32 {
    static constexpr bool PERM = false, AFTER_DRAIN = false;
    float* C; const float* res; int ldc; float alpha;
    __device__ __forceinline__ void operator()(const f32x4 (&acc)[2][2][4][2], const Unit& u, int wr, int wc, int fr, int fq) const {
        const int row0 = u.pm * BM + wr * 64 + fr, col0 = u.pn * BM + wc * 32 + 4 * fq;
#pragma unroll
        for (int ai = 0; ai < 2; ++ai)
#pragma unroll
            for (int m = 0; m < 4; ++m) { const size_t off = (size_t)(row0 + ai * HALF + m * 16) * ldc + col0;
#pragma unroll
                for (int bj = 0; bj < 2; ++bj)
#pragma unroll
                    for (int n = 0; n < 2; ++n) { const f32x4 r = *(const f32x4*)(res + off + bj * HALF + n * 16); *(f32x4*)(C + off + bj * HALF + n * 16) = r * alpha + acc[ai][bj][m][n]; } }
    }
};
struct EpiSwiglu {
    static constexpr bool PERM = true, AFTER_DRAIN = false;
    bf16_t* O; int ldc; int nN; int pm_off;
    __device__ __forceinline__ void operator()(const f32x4 (&acc)[2][2][4][2], const Unit& u, int wr, int wc, int fr, int fq) const {
        const int row0 = (u.pm - pm_off) * BM + wr * 64 + fr, col0 = (u.pn % nN) * HALF + wc * 32 + 8 * fq;
#pragma unroll
        for (int ai = 0; ai < 2; ++ai)
#pragma unroll
            for (int m = 0; m < 4; ++m) { bf16_t* rowp = O + (size_t)(row0 + ai * HALF + m * 16) * ldc + col0;
                const f32x4 g0 = acc[ai][0][m][0], g1 = acc[ai][0][m][1], u0 = acc[ai][1][m][0], u1 = acc[ai][1][m][1];
                u32x4 w;
                w.x = cvt_pk_bf16(fast_silu(g0[0]) * u0[0], fast_silu(g0[1]) * u0[1]); w.y = cvt_pk_bf16(fast_silu(g0[2]) * u0[2], fast_silu(g0[3]) * u0[3]);
                w.z = cvt_pk_bf16(fast_silu(g1[0]) * u1[0], fast_silu(g1[1]) * u1[1]); w.w = cvt_pk_bf16(fast_silu(g1[2]) * u1[2], fast_silu(g1[3]) * u1[3]);
                *(u32x4*)rowp = w; }
    }
};
struct EpiMoeOut {
    static constexpr bool PERM = true, AFTER_DRAIN = false;
    bf16_t* O; int ldc; int nN; int pm_off;
    __device__ __forceinline__ void operator()(const f32x4 (&acc)[2][2][4][2], const Unit& u, int wr, int wc, int fr, int fq) const {
        const int row0 = (u.pm - pm_off) * BM + wr * 64 + fr, col0 = (u.pn % nN) * BM + wc * 32 + 8 * fq;
#pragma unroll
        for (int ai = 0; ai < 2; ++ai)
#pragma unroll
            for (int m = 0; m < 4; ++m) { bf16_t* rowp = O + (size_t)(row0 + ai * HALF + m * 16) * ldc + col0;
#pragma unroll
                for (int bj = 0; bj < 2; ++bj) { const f32x4 v0 = acc[ai][bj][m][0], v1 = acc[ai][bj][m][1];
                    u32x4 w; w.x = cvt_pk_bf16(v0[0], v0[1]); w.y = cvt_pk_bf16(v0[2], v0[3]); w.z = cvt_pk_bf16(v1[0], v1[1]); w.w = cvt_pk_bf16(v1[2], v1[3]);
                    *(u32x4*)(rowp + bj * HALF) = w; } }
    }
};
struct EpiQKV1 {
    static constexpr bool PERM = true, AFTER_DRAIN = false;
    bf16_t* Q; bf16_t* Kb; bf16_t* Vb; const float* bias; float qscale;
    __device__ __forceinline__ void operator()(const f32x4 (&acc)[2][2][4][2], const Unit& u, int wr, int wc, int fr, int fq) const {
        const int row0 = u.pm * BM + wr * 64 + fr, cw = wc * 32 + 8 * fq, bcol0 = u.pn * BM + cw;
        const bool isq = u.pn < 4; const float sc = isq ? qscale : 1.f;
        f32x4 bv[2][2];
#pragma unroll
        for (int bj = 0; bj < 2; ++bj)
#pragma unroll
            for (int n = 0; n < 2; ++n) bv[bj][n] = *(const f32x4*)(bias + bcol0 + bj * HALF + 4 * n);
#pragma unroll
        for (int ai = 0; ai < 2; ++ai)
#pragma unroll
            for (int m = 0; m < 4; ++m) { const size_t row = (size_t)(row0 + ai * HALF + m * 16);
#pragma unroll
                for (int bj = 0; bj < 2; ++bj) { const f32x4 v0 = (acc[ai][bj][m][0] + bv[bj][0]) * sc, v1 = (acc[ai][bj][m][1] + bv[bj][1]) * sc;
                    u32x4 w; w.x = cvt_pk_bf16(v0[0], v0[1]); w.y = cvt_pk_bf16(v0[2], v0[3]); w.z = cvt_pk_bf16(v1[0], v1[1]); w.w = cvt_pk_bf16(v1[2], v1[3]);
                    bf16_t* dst = isq ? (Q + row * 1024 + u.pn * BM + bj * HALF + cw) : ((bj == 0 ? Kb : Vb) + row * 128 + cw);
                    *(u32x4*)dst = w; } }
    }
};
template <class Epi, class Sched, bool ALIGN_EPI = false, bool SP2 = false>
__device__ __forceinline__ void gemm_phase(PG8_LAS unsigned char* lds, const Gemm g, const Sched& S, const Epi& E) {
    const int tid = threadIdx.x, wid = __builtin_amdgcn_readfirstlane(tid >> 6), lane = tid & 63, wr = wid >> 2, wc = wid & 3, fr = lane & 15, fq = lane >> 4;
    const int K = g.K, nt = K / BK;
    unsigned voffA[2], voffB[2];
#pragma unroll
    for (int i = 0; i < 2; ++i) { int R, C; stage_rc(tid * 16 + i * 8192, R, C); const int Rb = Epi::PERM ? ((R & ~31) + perm32(R & 31)) : R;
        voffA[i] = (unsigned)(R * K + C) * 2u; voffB[i] = (unsigned)(Rb * K + C) * 2u; }
    const size_t kstep = (size_t)(BK * 2);
    const size_t hstep = (size_t)HALF * K * 2;
    const size_t tstep = 2 * hstep;
    const unsigned ldsw = (unsigned)wid * 1024u;
    const int aoff = lds_byte(wr * 64 + fr, fq * 8), boff = lds_byte(wc * 32 + fr, fq * 8);
#define PG8_SA(b, h) (((b) * 2 + (h)) * HTB)
#define PG8_SB(b, h) ((4 + (b) * 2 + (h)) * HTB)
#define PG8_STAGE(bufoff, gbase, voff) do { _Pragma("unroll") for (int _i = 0; _i < 2; ++_i) \
        __builtin_amdgcn_global_load_lds((const unsigned*)((const char*)(gbase) + (voff)[_i]), (PG8_LAS unsigned*)(lds + (bufoff) + ldsw + _i * 8192), 16, 0, 0); } while (0)
#define PG8_LDA(dst, b, h) do { _Pragma("unroll") for (int m = 0; m < 4; ++m) _Pragma("unroll") for (int k = 0; k < 2; ++k) dst[m][k] = *(const PG8_LAS bf16x8*)(lds + PG8_SA(b, h) + aoff + m * 2048 + k * 1024); } while (0)
#define PG8_LDB(dst, b, h) do { _Pragma("unroll") for (int n = 0; n < 2; ++n) _Pragma("unroll") for (int k = 0; k < 2; ++k) dst[n][k] = *(const PG8_LAS bf16x8*)(lds + PG8_SB(b, h) + boff + n * 2048 + k * 1024); } while (0)
#define PG8_MMA(ai, bj, At, Bt) do { __builtin_amdgcn_s_setprio(1); _Pragma("unroll") for (int m = 0; m < 4; ++m) _Pragma("unroll") for (int n = 0; n < 2; ++n) _Pragma("unroll") for (int k = 0; k < 2; ++k) \
        acc[ai][bj][m][n] = __builtin_amdgcn_mfma_f32_16x16x32_bf16(Bt[n][k], At[m][k], acc[ai][bj][m][n], 0, 0, 0); __builtin_amdgcn_s_setprio(0); } while (0)
#define PG8_WAIT_V(n) asm volatile("s_waitcnt vmcnt(" #n ")" ::: "memory")
#define PG8_WAIT_L(n) asm volatile("s_waitcnt lgkmcnt(" #n ")" ::: "memory")
#define PG8_BAR __builtin_amdgcn_s_barrier()
#define PG8_SCHED __builtin_amdgcn_sched_barrier(0)
    Unit cur, nxt; int ui = 0;
    if (!S.next(0, cur)) return;
    f32x4 acc[2][2][4][2];
#pragma unroll
    for (int a = 0; a < 2; ++a)
#pragma unroll
        for (int b = 0; b < 2; ++b)
#pragma unroll
            for (int m = 0; m < 4; ++m)
#pragma unroll
                for (int n = 0; n < 2; ++n) acc[a][b][m][n] = (f32x4){0.f, 0.f, 0.f, 0.f};
    bf16x8 At[4][2], B0[2][2], B1[2][2];
    const char* cA = (const char*)g.A + (size_t)cur.pm * tstep; const char* cB = (const char*)g.Bt + (size_t)cur.pn * tstep;
    S.a_ready(cur);
    if constexpr (SP2) {
        PG8_STAGE(PG8_SB(0, 0), cB, voffB); PG8_STAGE(PG8_SB(0, 1), cB + hstep, voffB); PG8_STAGE(PG8_SA(0, 0), cA, voffA); PG8_STAGE(PG8_SA(0, 1), cA + hstep, voffA);
        if (wr == 1) PG8_BAR;
        PG8_WAIT_V(2); PG8_BAR;
        PG8_STAGE(PG8_SB(1, 0), cB + kstep, voffB); PG8_STAGE(PG8_SA(1, 0), cA + kstep, voffA); PG8_STAGE(PG8_SB(1, 1), cB + hstep + kstep, voffB);
        PG8_WAIT_V(6); PG8_BAR;
    } else {
        PG8_STAGE(PG8_SB(0, 0), cB, voffB); PG8_STAGE(PG8_SA(0, 0), cA, voffA); PG8_STAGE(PG8_SB(0, 1), cB + hstep, voffB); PG8_STAGE(PG8_SA(0, 1), cA + hstep, voffA);
        if (wr == 1) PG8_BAR;
        PG8_WAIT_V(4); PG8_BAR;
        PG8_STAGE(PG8_SB(1, 0), cB + kstep, voffB); PG8_STAGE(PG8_SA(1, 0), cA + kstep, voffA); PG8_STAGE(PG8_SB(1, 1), cB + hstep + kstep, voffB);
        PG8_WAIT_V(6); PG8_BAR;
    }
    for (;;) {
        const bool has_next = S.next(ui + 1, nxt);
        const char* nA = has_next ? (const char*)g.A + (size_t)nxt.pm * tstep : cA; const char* nB = has_next ? (const char*)g.Bt + (size_t)nxt.pn * tstep : cB;
        for (int t = 0; t < nt; t += 2) {
            const bool last = (t == nt - 2);
            const char* a1 = cA + (size_t)(t + 1) * kstep;
            const char* a2 = last ? nA : cA + (size_t)(t + 2) * kstep; const char* b2 = last ? nB : cB + (size_t)(t + 2) * kstep;
            const char* a3 = a2 + kstep; const char* b3 = b2 + kstep;
            if (last && has_next) S.a_ready(nxt);
            if constexpr (SP2) {
            PG8_LDB(B0, 0, 0); PG8_LDB(B1, 0, 1); PG8_SCHED; PG8_LDA(At, 0, 0); PG8_STAGE(PG8_SA(1, 1), a1 + hstep, voffA);
            PG8_WAIT_V(8); PG8_WAIT_L(0); PG8_BAR; PG8_MMA(0, 0, At, B0); PG8_MMA(0, 1, At, B1); PG8_BAR; PG8_SCHED;
            PG8_LDA(At, 0, 1); PG8_STAGE(PG8_SB(0, 0), b2, voffB); PG8_STAGE(PG8_SB(0, 1), b2 + hstep, voffB); PG8_STAGE(PG8_SA(0, 0), a2, voffA);
            PG8_WAIT_V(8); PG8_WAIT_L(0); PG8_BAR; PG8_MMA(1, 0, At, B0); PG8_MMA(1, 1, At, B1); PG8_BAR; PG8_SCHED;
            PG8_LDB(B0, 1, 0); PG8_LDB(B1, 1, 1); PG8_SCHED; PG8_LDA(At, 1, 0); PG8_STAGE(PG8_SA(0, 1), a2 + hstep, voffA);
            PG8_WAIT_V(8); PG8_WAIT_L(0); PG8_BAR; PG8_MMA(0, 0, At, B0); PG8_MMA(0, 1, At, B1); PG8_BAR; PG8_SCHED;
            PG8_LDA(At, 1, 1); PG8_STAGE(PG8_SB(1, 0), b3, voffB); PG8_STAGE(PG8_SB(1, 1), b3 + hstep, voffB); PG8_STAGE(PG8_SA(1, 0), a3, voffA);
            PG8_WAIT_V(8); PG8_WAIT_L(0); PG8_BAR; PG8_MMA(1, 0, At, B0); PG8_MMA(1, 1, At, B1); PG8_BAR; PG8_SCHED;
            } else {
            PG8_LDB(B0, 0, 0); PG8_SCHED; PG8_LDA(At, 0, 0); PG8_STAGE(PG8_SA(1, 1), a1 + hstep, voffA);
            PG8_WAIT_L(8); PG8_BAR; PG8_WAIT_L(0); PG8_MMA(0, 0, At, B0); PG8_BAR; PG8_SCHED;
            PG8_LDB(B1, 0, 1); PG8_STAGE(PG8_SB(0, 0), b2, voffB);
            PG8_BAR; PG8_WAIT_L(0); PG8_MMA(0, 1, At, B1); PG8_BAR;
            PG8_LDA(At, 0, 1); PG8_STAGE(PG8_SA(0, 0), a2, voffA);
            PG8_BAR; PG8_WAIT_L(0); PG8_MMA(1, 0, At, B0); PG8_BAR; PG8_SCHED;
            PG8_STAGE(PG8_SB(0, 1), b2 + hstep, voffB);
            PG8_WAIT_V(6); PG8_BAR; PG8_MMA(1, 1, At, B1); PG8_BAR;
            PG8_LDB(B0, 1, 0); PG8_SCHED; PG8_LDA(At, 1, 0); PG8_STAGE(PG8_SA(0, 1), a2 + hstep, voffA);
            PG8_WAIT_L(8); PG8_BAR; PG8_WAIT_L(0); PG8_MMA(0, 0, At, B0); PG8_BAR; PG8_SCHED;
            PG8_LDB(B1, 1, 1); PG8_STAGE(PG8_SB(1, 0), b3, voffB);
            PG8_BAR; PG8_WAIT_L(0); PG8_MMA(0, 1, At, B1); PG8_BAR;
            PG8_LDA(At, 1, 1); PG8_STAGE(PG8_SA(1, 0), a3, voffA);
            PG8_BAR; PG8_WAIT_L(0); PG8_MMA(1, 0, At, B0); PG8_BAR; PG8_SCHED;
            PG8_STAGE(PG8_SB(1, 1), b3 + hstep, voffB);
            PG8_WAIT_V(6); PG8_BAR; PG8_MMA(1, 1, At, B1); PG8_BAR;
            }
        }
        if constexpr (ALIGN_EPI) { if (wr == 0) PG8_BAR; }
        if constexpr (!Epi::AFTER_DRAIN) { E(acc, cur, wr, wc, fr, fq); S.done(cur); }
        if (!has_next) break;
#pragma unroll
        for (int a = 0; a < 2; ++a)
#pragma unroll
            for (int b = 0; b < 2; ++b)
#pragma unroll
                for (int m = 0; m < 4; ++m)
#pragma unroll
                    for (int n = 0; n < 2; ++n) acc[a][b][m][n] = (f32x4){0.f, 0.f, 0.f, 0.f};
        cur = nxt; cA = nA; cB = nB; ++ui;
        if constexpr (ALIGN_EPI) { if (wr == 1) PG8_BAR; }
    }
    PG8_WAIT_V(0);
    if constexpr (!ALIGN_EPI) { if (wr == 0) PG8_BAR; }
    PG8_BAR;
    if constexpr (Epi::AFTER_DRAIN) { E.fused(acc, cur, wr, wc, fr, fq, lds, wid, lane); S.done(cur); }
#undef PG8_SA
#undef PG8_SB
#undef PG8_STAGE
#undef PG8_LDA
#undef PG8_LDB
#undef PG8_MMA
#undef PG8_WAIT_V
#undef PG8_WAIT_L
#undef PG8_BAR
#undef PG8_SCHED
}
}
constexpr int BATCH = 2, T = 8192, D = 1024, M = BATCH * T;
constexpr int GH = 8, CH = 64, NCH = T / CH;
constexpr int GIN = 3088, FF = 2816, NE = 8, ED = 3584;
constexpr float ALPHA = 1.4142135623730951f, LN_EPS = 1e-5f, GDN_EPS = 1e-6f, LOG2E = 1.4426950408889634f;
constexpr int NWAVES = 8;
constexpr size_t MiB = (size_t)1 << 20;
constexpr size_t WS_CTL = 0, CTL_ZERO_BYTES = 1 * MiB;
constexpr size_t WS_W0T = 1 * MiB, WS_WO0T = 7 * MiB, WS_WGU0T = 9 * MiB, WS_WD0T = 20 * MiB, WS_W1T = 26 * MiB, WS_WO1T = 29 * MiB;
constexpr size_t WS_ABLOG = 31 * MiB, WS_TOK = 32 * MiB;
constexpr size_t TOK_DL = 0, TOK_E = 64 * 1024, TOK_SLOT = 192 * 1024, TOK_W = 320 * 1024, TOK_ROW = 448 * 1024;
constexpr size_t WS_WGUT = 34 * MiB, WS_WDT = 146 * MiB, WS_ACT = 202 * MiB, WS_END = 458 * MiB;
constexpr size_t A_QK = 0, A_V = 32 * MiB, A_Z = 64 * MiB, A_U = 96 * MiB, A_WP = 128 * MiB, A_QD = 160 * MiB, A_KDT = 192 * MiB, A_AQK = 224 * MiB;
constexpr size_t A_OG = 0, A_H = 96 * MiB, A_X = 160 * MiB, A_XB = 224 * MiB, A_HACT = 0;
constexpr size_t A_Q1 = 0, A_K1 = 32 * MiB, A_V1 = 36 * MiB, A_OB = 40 * MiB;
constexpr size_t A_XG = 0, A_Y = 68 * MiB, A_HACT2 = 136 * MiB;
constexpr int MOE_MAXT = 136;
constexpr int MOE_PASS_T = 68;
static_assert(A_HACT2 + (size_t)MOE_PASS_T * 256 * ED * 2 <= 256 * MiB, "act map");
constexpr int CW_TMO = 0, CW_CODE = 1, CW_BAR = 4096, CW_MOE = 131072, CW_DBG = 196608;
constexpr int RING_BYTES = 131072, AUX_OFF = 131072, AUX_BYTES = 24576, LDSCTL_OFF = AUX_OFF + AUX_BYTES, LDS_BYTES = LDSCTL_OFF + 512;

#define GAS __attribute__((address_space(1)))
#define LAS __attribute__((address_space(3)))
typedef unsigned short bf16;
typedef unsigned v4u __attribute__((ext_vector_type(4)));
typedef unsigned v2u __attribute__((ext_vector_type(2)));
typedef float f32x4 __attribute__((ext_vector_type(4)));
typedef short bf16x8 __attribute__((ext_vector_type(8)));
typedef GAS unsigned gu32;
#define RLX_AGENT __ATOMIC_RELAXED, __HIP_MEMORY_SCOPE_AGENT
#define LDS_WAIT() asm volatile("s_waitcnt lgkmcnt(0)" ::: "memory")
#define VM_WAIT() asm volatile("s_waitcnt vmcnt(0)" ::: "memory")
__device__ __forceinline__ unsigned f2bf(float f) { unsigned u = __builtin_bit_cast(unsigned, f); return (u + 0x7fffu + ((u >> 16) & 1u)) >> 16; }
__device__ __forceinline__ unsigned pk2(float lo, float hi) { return f2bf(lo) | (f2bf(hi) << 16); }
__device__ __forceinline__ float bf2f(unsigned b) { return __builtin_bit_cast(float, b << 16); }
__device__ __forceinline__ float bflo(unsigned w) { return __builtin_bit_cast(float, w << 16); }
__device__ __forceinline__ float bfhi(unsigned w) { return __builtin_bit_cast(float, w & 0xffff0000u); }
__device__ __forceinline__ void unpack8(const v4u v, float (&o)[8]) { o[0] = bflo(v.x); o[1] = bfhi(v.x); o[2] = bflo(v.y); o[3] = bfhi(v.y); o[4] = bflo(v.z); o[5] = bfhi(v.z); o[6] = bflo(v.w); o[7] = bfhi(v.w); }
__device__ __forceinline__ v4u pack8(const float (&o)[8]) { v4u v; v.x = pk2(o[0], o[1]); v.y = pk2(o[2], o[3]); v.z = pk2(o[4], o[5]); v.w = pk2(o[6], o[7]); return v; }
__device__ __forceinline__ f32x4 mfma16(bf16x8 a, bf16x8 b, f32x4 c) { return __builtin_amdgcn_mfma_f32_16x16x32_bf16(a, b, c, 0, 0, 0); }
__device__ __forceinline__ bf16x8 frag_from(const f32x4 lo, const f32x4 hi) {
    v4u v; v.x = pk2(lo[0], lo[1]); v.y = pk2(lo[2], lo[3]); v.z = pk2(hi[0], hi[1]); v.w = pk2(hi[2], hi[3]); return __builtin_bit_cast(bf16x8, v); }
__device__ __forceinline__ float wave_sum(float v) {
#pragma unroll
    for (int o = 1; o < 64; o <<= 1) v += __shfl_xor(v, o);
    return v;
}
__device__ __forceinline__ float rdlane(float v, int l) { return __builtin_bit_cast(float, __builtin_amdgcn_readlane(__builtin_bit_cast(int, v), l)); }

#define XB_TMO      128
#define XB_XCNT(j)  (256  + 64 * (j))
#define XB_XSUB(j)  (1280 + 64 * (j))
#define XB_XGEN(j)  (2304 + 64 * (j))
#define XB_TOP      3328
#define XB_TOPGEN   3392
#define XCD_BAR_WORDS 3456
#define XB_SPIN_CAP (1u << 18)

__device__ __forceinline__ unsigned xb_ld(unsigned* p)              { return __hip_atomic_load(p, __ATOMIC_RELAXED, __HIP_MEMORY_SCOPE_AGENT); }
__device__ __forceinline__ unsigned xb_add(unsigned* p, unsigned v) { return __hip_atomic_fetch_add(p, v, __ATOMIC_RELAXED, __HIP_MEMORY_SCOPE_AGENT); }
__device__ __forceinline__ unsigned xb_xcc_id() { return (unsigned)__builtin_amdgcn_s_getreg((3 << 11) | 20) & 0xFu; }
#define XB_SPIN(cond, bar) do { unsigned _sp = 0; while (cond) { __builtin_amdgcn_s_sleep(1); \
    if ((++_sp & 255u) == 0u) { if (xb_ld(&(bar)[XB_TMO])) break; if (_sp > XB_SPIN_CAP) { atomicAdd(&(bar)[XB_TMO], 1u); break; } } } } while (0)

struct XcdBarrier {
    unsigned* bar; unsigned x;
    volatile LAS unsigned* st;
};

__device__ __forceinline__ XcdBarrier xcd_barrier_post(unsigned* bar, volatile LAS unsigned* st) {
    XcdBarrier b; b.bar = bar; b.x = xb_xcc_id(); b.st = st;
    if (threadIdx.x == 0) (void)xb_add(&bar[XB_XCNT(b.x)], 1u);
    return b;
}
__device__ __forceinline__ void xcd_barrier_complete(unsigned* bar, unsigned x, unsigned& nloc, unsigned& nx) {
    const unsigned G = gridDim.x * gridDim.y * gridDim.z;
    unsigned sum, cnt, mine, sp = 0u;
    for (;;) {
        sum = 0u; cnt = 0u; mine = 0u;
#pragma unroll
        for (unsigned j = 0; j < 16; ++j) { const unsigned c = xb_ld(&bar[XB_XCNT(j)]); sum += c; cnt += (c > 0u) ? 1u : 0u; mine = (j == x) ? c : mine; }
        if (sum == G) break;
        __builtin_amdgcn_s_sleep(1);
        if ((++sp & 255u) == 0u) { if (xb_ld(&bar[XB_TMO])) break; if (sp > XB_SPIN_CAP) { atomicAdd(&bar[XB_TMO], 1u); break; } }
    }
    nloc = mine > 0u ? mine : 1u; nx = cnt > 0u ? cnt : 1u;
}

__device__ __forceinline__ void xcd_barrier(const XcdBarrier& b) {
    asm volatile("s_waitcnt vmcnt(0)" ::: "memory");
    __syncthreads();
    if (threadIdx.x == 0) {
        unsigned* bar = b.bar;
        __builtin_amdgcn_s_waitcnt(0);
        unsigned nloc = b.st[0], nx = b.st[1];
        if (nloc == 0u) { xcd_barrier_complete(bar, b.x, nloc, nx); b.st[0] = nloc; b.st[1] = nx; }
        const unsigned old = xb_add(&bar[XB_XSUB(b.x)], 1u);
        const unsigned gen = old / nloc;
        if (old + 1u == (gen + 1u) * nloc) {
            __builtin_amdgcn_fence(__ATOMIC_RELEASE, "agent");
            asm volatile("s_waitcnt vmcnt(0)" ::: "memory");
            const unsigned og = xb_add(&bar[XB_TOP], 1u);
            const unsigned tg = og / nx;
            if (og + 1u == (tg + 1u) * nx) xb_add(&bar[XB_TOPGEN], 1u);
            else XB_SPIN(xb_ld(&bar[XB_TOPGEN]) == tg, bar);
            __builtin_amdgcn_fence(__ATOMIC_ACQUIRE, "agent");
            xb_add(&bar[XB_XGEN(b.x)], 1u);
            asm volatile("s_waitcnt vmcnt(0)" ::: "memory");
        } else {
            XB_SPIN(xb_ld(&bar[XB_XGEN(b.x)]) == gen, bar);
            __builtin_amdgcn_fence(__ATOMIC_ACQUIRE, "agent");
            asm volatile("s_waitcnt vmcnt(0)" ::: "memory");
        }
    }
    __syncthreads();
}
struct Args { const float* in[21]; float* out; unsigned char* ws; int ph_lo, ph_hi, li, dbg; };
struct Frame {
    LAS unsigned char* lds; volatile LAS unsigned* MISC; gu32* ctl; unsigned char* ws;
    int tid, lane, wave, vcu, G;
};
template <class TT> __device__ __forceinline__ TT* actp(const Frame& F, size_t off) { return (TT*)(F.ws + WS_ACT + off); }

__device__ __forceinline__ void transpose_item(const float* W, int ldw, int nblk, bf16* WT, int ldt, int mode, int item, LAS float* scr, int lane) {
    const int kb = item / nblk, nb = item - kb * nblk, k0 = 64 * kb, n0 = 32 * nb;
    const int drow0 = mode == 0 ? n0 : ((n0 >> 7) * 256 + (n0 & 127) + (mode == 2 ? 128 : 0));
#pragma unroll 8
    for (int i = 0; i < 32; ++i) { const int kk = 2 * i + (lane >> 5); scr[kk * 33 + (lane & 31)] = W[(size_t)(k0 + kk) * ldw + n0 + (lane & 31)]; }
    LDS_WAIT(); asm volatile("" ::: "memory");
    const int c = lane & 7;
#pragma unroll
    for (int j = 0; j < 4; ++j) { const int n = (lane >> 3) + 8 * j; const LAS float* s = scr + (8 * c) * 33 + n;
        v4u o; o.x = pk2(s[0 * 33], s[1 * 33]); o.y = pk2(s[2 * 33], s[3 * 33]); o.z = pk2(s[4 * 33], s[5 * 33]); o.w = pk2(s[6 * 33], s[7 * 33]);
        *(GAS v4u*)(WT + (size_t)(drow0 + n) * ldt + k0 + 8 * c) = o; }
    LDS_WAIT(); asm volatile("" ::: "memory");
}
__device__ __forceinline__ void p0_prologue(Frame& F, const Args& a) {
    LAS float* scr = (LAS float*)(F.lds + F.wave * 16384);
    const int gw = F.vcu * NWAVES + F.wave, NGW = F.G * NWAVES;
    constexpr int I0 = 16 * 96, I1 = 16 * 32, I2 = 16 * 88, I3 = I2, I4 = 44 * 32, I5 = 16 * 40, I6 = 16 * 32, NIT = I0 + I1 + I2 + I3 + I4 + I5 + I6;
    unsigned char* ws = F.ws;
    for (int it = gw; it < NIT; it += NGW) {
        int r = it;
        if (r < I0) { transpose_item(a.in[1], GIN, 96, (bf16*)(ws + WS_W0T), D, 0, r, scr, F.lane); continue; } r -= I0;
        if (r < I1) { transpose_item(a.in[6], D, 32, (bf16*)(ws + WS_WO0T), D, 0, r, scr, F.lane); continue; } r -= I1;
        if (r < I2) { transpose_item(a.in[12], FF, 88, (bf16*)(ws + WS_WGU0T), D, 1, r, scr, F.lane); continue; } r -= I2;
        if (r < I3) { transpose_item(a.in[13], FF, 88, (bf16*)(ws + WS_WGU0T), D, 2, r, scr, F.lane); continue; } r -= I3;
        if (r < I4) { transpose_item(a.in[14], D, 32, (bf16*)(ws + WS_WD0T), FF, 0, r, scr, F.lane); continue; } r -= I4;
        if (r < I5) { transpose_item(a.in[7], 1280, 40, (bf16*)(ws + WS_W1T), D, 0, r, scr, F.lane); continue; } r -= I5;
        transpose_item(a.in[10], D, 32, (bf16*)(ws + WS_WO1T), D, 0, r, scr, F.lane);
    }
    { const GAS f32x4* xs = (const GAS f32x4*)a.in[0]; GAS v4u* xd = (GAS v4u*)a.out;
      const size_t n8 = (size_t)M * D / 8, gt = (size_t)F.vcu * 512 + F.tid, NT = (size_t)F.G * 512;
      for (size_t i = gt; i < n8; i += NT) { const f32x4 p = xs[2 * i], q = xs[2 * i + 1]; v4u o; o.x = pk2(p[0], p[1]); o.y = pk2(p[2], p[3]); o.z = pk2(q[0], q[1]); o.w = pk2(q[2], q[3]); xd[i] = o; } }
    __syncthreads();
    { LAS float* wl = (LAS float*)F.lds; const float* win = a.in[1];
      for (int i = F.tid; i < 1024 * 16; i += 512) { const int k = i >> 4, j = i & 15; wl[k * 20 + j] = win[(size_t)k * GIN + 3072 + j]; }
      __syncthreads();
      float* ablog = (float*)(ws + WS_ABLOG);
      for (int m = gw; m < M; m += NGW) {
          const float* xr = a.in[0] + (size_t)m * D;
          float acc[16];
#pragma unroll
          for (int j = 0; j < 16; ++j) acc[j] = 0.f;
#pragma unroll 4
          for (int i = 0; i < 16; ++i) { const int k = F.lane + 64 * i; const float xv = xr[k]; const LAS f32x4* wr = (const LAS f32x4*)(wl + k * 20);
#pragma unroll
              for (int q = 0; q < 4; ++q) { const f32x4 w = wr[q]; acc[4 * q] += xv * w[0]; acc[4 * q + 1] += xv * w[1]; acc[4 * q + 2] += xv * w[2]; acc[4 * q + 3] += xv * w[3]; } }
#pragma unroll
          for (int j = 0; j < 16; ++j) acc[j] = wave_sum(acc[j]);
          if (F.lane == 0) { GAS f32x4* o = (GAS f32x4*)(ablog + (size_t)m * 16);
              o[0] = (f32x4){acc[0], acc[1], acc[2], acc[3]}; o[1] = (f32x4){acc[4], acc[5], acc[6], acc[7]}; o[2] = (f32x4){acc[8], acc[9], acc[10], acc[11]}; o[3] = (f32x4){acc[12], acc[13], acc[14], acc[15]}; }
      }
      __syncthreads(); }
}
__device__ __forceinline__ void moe_weight_copies(Frame& F, const Args& a, int gw, int NGW) {
    LAS float* scr = (LAS float*)(F.lds + F.wave * 16384);
    constexpr int PER = 1792, NIT = NE * 3 * PER;
    for (int it = gw; it < NIT; it += NGW) {
        const int e = it / (3 * PER), r = it - e * 3 * PER, which = r / PER, item = r - which * PER;
        bf16* gu = (bf16*)(F.ws + WS_WGUT) + (size_t)e * 2 * ED * D; bf16* dn = (bf16*)(F.ws + WS_WDT) + (size_t)e * D * ED;
        if (which == 0) transpose_item(a.in[16] + (size_t)e * D * ED, ED, 112, gu, D, 1, item, scr, F.lane);
        else if (which == 1) transpose_item(a.in[17] + (size_t)e * D * ED, ED, 112, gu, D, 2, item, scr, F.lane);
        else transpose_item(a.in[18] + (size_t)e * ED * D, D, 32, dn, ED, 0, item, scr, F.lane);
    }
}

__device__ __forceinline__ void ln_core(f32x4 (&v)[4], const f32x4 (&g)[4], const f32x4 (&bb)[4]) {
    float s = 0.f;
#pragma unroll
    for (int j = 0; j < 4; ++j) s += (v[j][0] + v[j][1]) + (v[j][2] + v[j][3]);
    const float mean = wave_sum(s) * (1.f / D); float s2 = 0.f;
#pragma unroll
    for (int j = 0; j < 4; ++j) { v[j] = v[j] - mean; s2 += (v[j][0] * v[j][0] + v[j][1] * v[j][1]) + (v[j][2] * v[j][2] + v[j][3] * v[j][3]); }
    const float rstd = 1.f / sqrtf(wave_sum(s2) * (1.f / D) + LN_EPS);
#pragma unroll
    for (int j = 0; j < 4; ++j) v[j] = v[j] * rstd * g[j] + bb[j];
}
__device__ __forceinline__ void ln_phase(Frame& F, const float* src, const float* g, const float* b, float* dstf, bf16* dstb) {
    const int gw = F.vcu * NWAVES + F.wave, NGW = F.G * NWAVES;
    f32x4 gv[4], bv[4];
#pragma unroll
    for (int j = 0; j < 4; ++j) { gv[j] = ((const GAS f32x4*)g)[F.lane + 64 * j]; bv[j] = ((const GAS f32x4*)b)[F.lane + 64 * j]; }
    for (int m = gw; m < M; m += NGW) {
        const GAS f32x4* xr = (const GAS f32x4*)(src + (size_t)m * D) + F.lane; f32x4 v[4];
#pragma unroll
        for (int j = 0; j < 4; ++j) v[j] = xr[64 * j];
        ln_core(v, gv, bv);
        GAS f32x4* of = (GAS f32x4*)(dstf + (size_t)m * D) + F.lane; GAS v2u* ob = (GAS v2u*)(dstb + (size_t)m * D) + F.lane;
#pragma unroll
        for (int j = 0; j < 4; ++j) { of[64 * j] = v[j]; v2u o; o.x = pk2(v[j][0], v[j][1]); o.y = pk2(v[j][2], v[j][3]); ob[64 * j] = o; }
    }
}

__device__ __forceinline__ void ln3_router_phase(Frame& F, const Args& a) {
    const float* src = actp<float>(F, A_H); const float* g = a.in[19] + 2 * D; const float* b = a.in[20] + 2 * D;
    float* dstf = a.out; bf16* dstb = actp<bf16>(F, A_XB);
    LAS float* wrT = (LAS float*)F.lds;
    LAS int* lcnt = (LAS int*)(F.lds + AUX_OFF);
    for (int i = F.tid; i < 8192; i += 512) { const int k = i >> 3, e = i & 7; wrT[e * 1024 + k] = a.in[15][i]; }
    f32x4 gv[4], bv[4];
#pragma unroll
    for (int j = 0; j < 4; ++j) { gv[j] = ((const GAS f32x4*)g)[F.lane + 64 * j]; bv[j] = ((const GAS f32x4*)b)[F.lane + 64 * j]; }
    gu32* gcnt = F.ctl + CW_MOE;
    int* tok_e = (int*)(F.ws + WS_TOK + TOK_E); int* tok_slot = (int*)(F.ws + WS_TOK + TOK_SLOT); float* tok_w = (float*)(F.ws + WS_TOK + TOK_W);
    for (int blk = F.vcu; blk < M / 64; blk += F.G) {
        if (F.tid < 16) lcnt[F.tid] = 0;
        __syncthreads();
        int my_e1 = 0, my_e2 = 0, my_l1 = 0, my_l2 = 0; float my_w1 = 0.f;
#pragma unroll 1
        for (int i = 0; i < 8; ++i) {
            const int m = blk * 64 + F.wave * 8 + i;
            const GAS f32x4* xr = (const GAS f32x4*)(src + (size_t)m * D) + F.lane; f32x4 v[4];
#pragma unroll
            for (int j = 0; j < 4; ++j) v[j] = xr[64 * j];
            ln_core(v, gv, bv);
            GAS f32x4* of = (GAS f32x4*)(dstf + (size_t)m * D) + F.lane; GAS v2u* ob = (GAS v2u*)(dstb + (size_t)m * D) + F.lane;
#pragma unroll
            for (int j = 0; j < 4; ++j) { of[64 * j] = v[j]; v2u o; o.x = pk2(v[j][0], v[j][1]); o.y = pk2(v[j][2], v[j][3]); ob[64 * j] = o; }
            float lg[8];
#pragma unroll
            for (int e = 0; e < 8; ++e) { float s = 0.f;
#pragma unroll
                for (int j = 0; j < 4; ++j) { const f32x4 w = ((const LAS f32x4*)(wrT + e * 1024))[F.lane + 64 * j]; s += v[j][0] * w[0] + v[j][1] * w[1] + v[j][2] * w[2] + v[j][3] * w[3]; }
                lg[e] = wave_sum(s); }
            int e1 = 0; float l1 = lg[0];
#pragma unroll
            for (int e = 1; e < 8; ++e) if (lg[e] > l1) { l1 = lg[e]; e1 = e; }
            int e2 = -1; float l2 = -3.0e38f;
#pragma unroll
            for (int e = 0; e < 8; ++e) if (e != e1 && lg[e] > l2) { l2 = lg[e]; e2 = e; }
            const float w1 = 1.f / (1.f + expf(l2 - l1));
            int p1 = 0, p2 = 0;
            if (F.lane == 0) { p1 = __hip_atomic_fetch_add(lcnt + e1, 1, __ATOMIC_RELAXED, __HIP_MEMORY_SCOPE_WORKGROUP); p2 = __hip_atomic_fetch_add(lcnt + e2, 1, __ATOMIC_RELAXED, __HIP_MEMORY_SCOPE_WORKGROUP); }
            p1 = __builtin_amdgcn_readfirstlane(p1); p2 = __builtin_amdgcn_readfirstlane(p2);
            if (F.lane == i) { my_e1 = e1; my_e2 = e2; my_l1 = p1; my_l2 = p2; my_w1 = w1; }
        }
        __syncthreads();
        if (F.tid < 8) lcnt[8 + F.tid] = (int)__hip_atomic_fetch_add(gcnt + 64 * F.tid, (unsigned)lcnt[F.tid], RLX_AGENT);
        __syncthreads();
        if (F.lane < 8) { const int m = blk * 64 + F.wave * 8 + F.lane;
            tok_e[2 * m] = my_e1; tok_e[2 * m + 1] = my_e2; tok_slot[2 * m] = lcnt[8 + my_e1] + my_l1; tok_slot[2 * m + 1] = lcnt[8 + my_e2] + my_l2;
            tok_w[2 * m] = my_w1; tok_w[2 * m + 1] = 1.f - my_w1; }
        __syncthreads();
    }
}
__device__ __forceinline__ void moe_offsets(Frame& F, LAS int* off  , LAS int* tile_e  ) {
    if (F.tid == 0) { int o = 0;
        for (int e = 0; e < 8; ++e) { off[e] = o; const int c = (int)__hip_atomic_load(F.ctl + CW_MOE + 64 * e, RLX_AGENT); o += (c + 255) & ~255; }
        if (o > MOE_MAXT * 256) o = MOE_MAXT * 256;
        off[8] = o; }
    __syncthreads();
    if (F.tid < MOE_MAXT) { int e = 0; const int r = F.tid * 256;
#pragma unroll
        for (int k = 1; k < 8; ++k) if (r >= off[k]) e = k;
        tile_e[F.tid] = e; }
    __syncthreads();
}
__device__ __forceinline__ void gather_phase(Frame& F) {
    LAS int* off = (LAS int*)(F.lds + AUX_OFF); LAS int* tile_e = off + 16;
    moe_offsets(F, off, tile_e);
    const int gw = F.vcu * NWAVES + F.wave, NGW = F.G * NWAVES;
    const int* tok_e = (const int*)(F.ws + WS_TOK + TOK_E); const int* tok_slot = (const int*)(F.ws + WS_TOK + TOK_SLOT); int* tok_row = (int*)(F.ws + WS_TOK + TOK_ROW);
    const bf16* xb = actp<bf16>(F, A_XB); bf16* xg = actp<bf16>(F, A_XG);
    for (int p = gw; p < 2 * M; p += NGW) {
        const int m = p >> 1; const int e = tok_e[p], s = tok_slot[p]; const int row = off[e] + s;
        const GAS v4u* src = (const GAS v4u*)(xb + (size_t)m * D) + F.lane; GAS v4u* dst = (GAS v4u*)(xg + (size_t)row * D) + F.lane;
        const v4u v0 = src[0], v1 = src[64]; dst[0] = v0; dst[64] = v1;
        if (F.lane == 0) tok_row[p] = row;
    }
}
__device__ __forceinline__ void final_phase(Frame& F, const Args& a) {
    const int gw = F.vcu * NWAVES + F.wave, NGW = F.G * NWAVES;
    const float* g = a.in[19] + 3 * D; const float* b = a.in[20] + 3 * D;
    f32x4 gv[4], bv[4];
#pragma unroll
    for (int j = 0; j < 4; ++j) { gv[j] = ((const GAS f32x4*)g)[F.lane + 64 * j]; bv[j] = ((const GAS f32x4*)b)[F.lane + 64 * j]; }
    const int* tok_row = (const int*)(F.ws + WS_TOK + TOK_ROW); const float* tok_w = (const float*)(F.ws + WS_TOK + TOK_W);
    const bf16* y = actp<bf16>(F, A_Y);
    for (int m = gw; m < M; m += NGW) {
        const int r1 = tok_row[2 * m], r2 = tok_row[2 * m + 1]; const float w1 = tok_w[2 * m], w2 = tok_w[2 * m + 1];
        GAS f32x4* xr = (GAS f32x4*)(a.out + (size_t)m * D) + F.lane; const GAS v2u* y1 = (const GAS v2u*)(y + (size_t)r1 * D) + F.lane; const GAS v2u* y2 = (const GAS v2u*)(y + (size_t)r2 * D) + F.lane;
        f32x4 v[4];
#pragma unroll
        for (int j = 0; j < 4; ++j) { const f32x4 x = xr[64 * j]; const v2u p = y1[64 * j], q = y2[64 * j];
            v[j][0] = ALPHA * x[0] + w1 * bflo(p.x) + w2 * bflo(q.x); v[j][1] = ALPHA * x[1] + w1 * bfhi(p.x) + w2 * bfhi(q.x);
            v[j][2] = ALPHA * x[2] + w1 * bflo(p.y) + w2 * bflo(q.y); v[j][3] = ALPHA * x[3] + w1 * bfhi(p.y) + w2 * bfhi(q.y); }
        ln_core(v, gv, bv);
#pragma unroll
        for (int j = 0; j < 4; ++j) xr[64 * j] = v[j];
    }
}
struct MoeOrder {
    int t_lo, nT, nN, nwg, G, c; const LAS int* tile_e;
    __device__ __forceinline__ void init(int t_lo_, int t_hi_, int nN_, int G_, int c_, const LAS int* te) { t_lo = t_lo_; nT = t_hi_ > t_lo_ ? t_hi_ - t_lo_ : 0; nN = nN_; nwg = nT * nN; G = G_; c = c_; tile_e = te; }
    __device__ __forceinline__ bool next(int i, pg8::Unit& u) const {
        const long L = (long)i * G + c; if (L >= nwg) return false;
        int wgid = (int)L; { const int q = nwg / 8, r = nwg % 8, xcd = wgid % 8, o = wgid / 8; wgid = (xcd < r ? xcd * (q + 1) : r * (q + 1) + (xcd - r) * q) + o; }
        const int nig = 8 * nN, gid = wgid / nig, fm = gid * 8, gsz = (nT - fm) < 8 ? (nT - fm) : 8;
        const int pm = t_lo + fm + ((wgid % nig) % gsz), pnl = (wgid % nig) / gsz;
        u.pm = pm; u.pn = tile_e[pm] * nN + pnl; return true;
    }
    __device__ __forceinline__ void a_ready(const pg8::Unit&) const {}
    __device__ __forceinline__ void done(const pg8::Unit&) const {}
};
constexpr int L_QS = 0, L_KS = 17408, L_VBT = 34816, L_KGT = 53248, L_A = 71680, L_TB = 89088, L_G = 98304;
__device__ __forceinline__ void load_row8(const bf16* base, int t, float (&o)[8]) {
    if (t >= 0) { const v4u v = *(const GAS v4u*)(base + (size_t)t * 1024); unpack8(v, o); }
    else {
#pragma unroll
        for (int e = 0; e < 8; ++e) o[e] = 0.f; }
}
__device__ __forceinline__ void cl_phase(Frame& F, const Args& a) {
    const bf16* QK = actp<bf16>(F, A_QK); const bf16* V = actp<bf16>(F, A_V);
    bf16* U = actp<bf16>(F, A_U); bf16* WP = actp<bf16>(F, A_WP); bf16* QD = actp<bf16>(F, A_QD); bf16* KDT = actp<bf16>(F, A_KDT); bf16* AQK = actp<bf16>(F, A_AQK);
    const float* ablog = (const float*)(F.ws + WS_ABLOG); float* DL = (float*)(F.ws + WS_TOK + TOK_DL);
    const float* conv_w = a.in[2]; const float* a_log = a.in[3]; const float* dt_bias = a.in[4];
    LAS unsigned char* L = F.lds;
    LAS float* gcs = (LAS float*)(L + L_G); LAS float* betas = gcs + 64; LAS float* As = (LAS float*)(L + L_A);
    const int lane = F.lane, w = F.wave, fr = lane & 15, fq = lane >> 4;
    for (int u = F.vcu; u < BATCH * NCH * GH; u += F.G) {
        const int b = u >> 10, n = (u >> 3) & 127, h = u & 7, kh = h >> 1;
        const size_t uidx = (size_t)(b * GH + h) * NCH + n;
        float beta, gc, glast;
        { const int mrow = b * T + n * 64 + lane;
          const float bl = ablog[(size_t)mrow * 16 + h], al = ablog[(size_t)mrow * 16 + 8 + h];
          beta = 1.f / (1.f + expf(-bl));
          const float xx = al + dt_bias[h]; const float sp = fmaxf(xx, 0.f) + log1pf(expf(-fabsf(xx)));
          gc = -expf(a_log[h]) * sp;
#pragma unroll
          for (int d = 1; d < 64; d <<= 1) { const float t = __shfl_up(gc, d); if (lane >= d) gc += t; }
          glast = rdlane(gc, 63);
          if (w == 0) { gcs[lane] = gc; betas[lane] = beta; if (lane == 0) DL[uidx] = expf(glast); } }
        if (fq < 3) {
            const int tb = n * 64 + 8 * w;
            const bf16* src; int ch;
            if (fq == 0) { src = QK + (size_t)b * T * 1024 + kh * 128 + 8 * fr; ch = kh * 128 + 8 * fr; }
            else if (fq == 1) { src = QK + (size_t)b * T * 1024 + 512 + kh * 128 + 8 * fr; ch = 512 + kh * 128 + 8 * fr; }
            else { src = V + (size_t)b * T * 1024 + h * 128 + 8 * fr; ch = 1024 + h * 128 + 8 * fr; }
            float cw[4][8];
#pragma unroll
            for (int j = 0; j < 4; ++j) { const f32x4 p = *(const GAS f32x4*)(conv_w + j * 2048 + ch), q = *(const GAS f32x4*)(conv_w + j * 2048 + ch + 4);
                cw[j][0] = p[0]; cw[j][1] = p[1]; cw[j][2] = p[2]; cw[j][3] = p[3]; cw[j][4] = q[0]; cw[j][5] = q[1]; cw[j][6] = q[2]; cw[j][7] = q[3]; }
            float x0[8], x1[8], x2[8], x3[8];
            load_row8(src, tb - 3, x0); load_row8(src, tb - 2, x1); load_row8(src, tb - 1, x2);
#pragma unroll
            for (int i = 0; i < 8; ++i) {
                load_row8(src, tb + i, x3);
                float o[8]; float ss = 0.f;
#pragma unroll
                for (int e = 0; e < 8; ++e) { const float c = cw[0][e] * x0[e] + cw[1][e] * x1[e] + cw[2][e] * x2[e] + cw[3][e] * x3[e]; o[e] = c / (1.f + expf(-c)); ss += o[e] * o[e]; }
#pragma unroll
                for (int e = 0; e < 8; ++e) { x0[e] = x1[e]; x1[e] = x2[e]; x2[e] = x3[e]; }
                ss += __shfl_xor(ss, 1); ss += __shfl_xor(ss, 2); ss += __shfl_xor(ss, 4); ss += __shfl_xor(ss, 8);
                const int r = 8 * w + i; const float br = rdlane(beta, r), gr = rdlane(gc, r);
                const float rs = 1.f / sqrtf(ss + GDN_EPS);
                if (fq == 0) {
#pragma unroll
                    for (int e = 0; e < 8; ++e) o[e] *= rs * 0.08838834764831845f;
                    *(LAS v4u*)(L + L_QS + r * 272 + fr * 16) = pack8(o);
                } else if (fq == 1) {
#pragma unroll
                    for (int e = 0; e < 8; ++e) o[e] *= rs;
                    *(LAS v4u*)(L + L_KS + r * 272 + fr * 16) = pack8(o);
                    const float sc = br * expf(gr);
#pragma unroll
                    for (int e = 0; e < 8; ++e) *(LAS bf16*)(L + L_KGT + (8 * fr + e) * 144 + r * 2) = (bf16)f2bf(o[e] * sc);
                } else {
#pragma unroll
                    for (int e = 0; e < 8; ++e) *(LAS bf16*)(L + L_VBT + (8 * fr + e) * 144 + r * 2) = (bf16)f2bf(o[e] * br);
                }
            }
        }
        __syncthreads();
        {
            const bool isqk = w >= 4; const int mt = w & 3;
            bf16x8 af[4];
#pragma unroll
            for (int ks = 0; ks < 4; ++ks) af[ks] = *(const LAS bf16x8*)(L + L_KS + (16 * mt + fr) * 272 + (32 * ks + 8 * fq) * 2);
#pragma unroll
            for (int nt = 0; nt < 4; ++nt) {
                f32x4 c = (f32x4){0.f, 0.f, 0.f, 0.f};
                const bool need = isqk ? (mt <= nt) : (nt <= mt);
                if (need) {
#pragma unroll
                    for (int ks = 0; ks < 4; ++ks) { const bf16x8 bfr = *(const LAS bf16x8*)(L + (isqk ? L_QS : L_KS) + (16 * nt + fr) * 272 + (32 * ks + 8 * fq) * 2); c = mfma16(af[ks], bfr, c); }
                }
                const int col = 16 * nt + fr;
                if (!isqk) {
                    const float gj = gcs[col];
#pragma unroll
                    for (int r = 0; r < 4; ++r) { const int i = 16 * mt + 4 * fq + r; const float v = (col < i) ? betas[i] * c[r] * expf(gcs[i] - gj) : 0.f; As[i * 68 + col] = v; }
                } else {
                    const float gi = gcs[col]; float o4[4];
#pragma unroll
                    for (int r = 0; r < 4; ++r) { const int s = 16 * mt + 4 * fq + r; o4[r] = (s <= col) ? c[r] * expf(gi - gcs[s]) : 0.f; }
                    v2u o; o.x = pk2(o4[0], o4[1]); o.y = pk2(o4[2], o4[3]);
                    *(GAS v2u*)(AQK + uidx * 4096 + col * 64 + 32 * (mt >> 1) + 8 * fq + 4 * (mt & 1)) = o;
                }
            }
        }
        __syncthreads();
        if (w == 0) {
            float x[64]; float flane = (float)lane; asm volatile("" : "+v"(flane));
#pragma unroll
            for (int i = 0; i < 64; ++i) x[i] = 0.f;
#pragma unroll
            for (int i = 0; i < 64; ++i) {
                float s0 = 0.f, s1 = 0.f, s2 = 0.f, s3 = 0.f;
#pragma unroll
                for (int j4 = 0; j4 < i; j4 += 4) { const f32x4 av = *(const LAS f32x4*)(As + i * 68 + j4); s0 += av[0] * x[j4]; s1 += av[1] * x[j4 + 1]; s2 += av[2] * x[j4 + 2]; s3 += av[3] * x[j4 + 3]; }
                x[i] = fmaxf(0.f, 1.f - fabsf(flane - (float)i)) - ((s0 + s1) + (s2 + s3));
                __builtin_amdgcn_sched_barrier(0);
            }
#pragma unroll
            for (int i = 0; i < 64; ++i) *(LAS bf16*)(L + L_TB + i * 144 + lane * 2) = (bf16)f2bf(x[i]);
        } else {
            const int idx = (w - 1) * 64 + lane;
            for (int p = idx; p < 1024; p += 448) {
                const int i = p >> 4, c16 = p & 15, d0 = 32 * (c16 >> 2) + 4 * (c16 & 3);
                const v2u lo = *(const LAS v2u*)(L + L_QS + i * 272 + d0 * 2), hi = *(const LAS v2u*)(L + L_QS + i * 272 + (d0 + 16) * 2);
                const float eg = expf(gcs[i]);
                v4u o; o.x = pk2(bflo(lo.x) * eg, bfhi(lo.x) * eg); o.y = pk2(bflo(lo.y) * eg, bfhi(lo.y) * eg); o.z = pk2(bflo(hi.x) * eg, bfhi(hi.x) * eg); o.w = pk2(bflo(hi.y) * eg, bfhi(hi.y) * eg);
                *(GAS v4u*)(QD + uidx * 8192 + i * 128 + c16 * 8) = o;
            }
            const float gl = gcs[63];
            for (int p = idx; p < 1024; p += 448) {
                const int dk = p >> 3, c8 = p & 7, t0 = 32 * (c8 >> 2) + 4 * (c8 & 3);
                float o[8];
#pragma unroll
                for (int j = 0; j < 8; ++j) { const int tk = t0 + 16 * (j >> 2) + (j & 3); o[j] = bf2f(*(const LAS bf16*)(L + L_KS + tk * 272 + dk * 2)) * expf(gl - gcs[tk]); }
                *(GAS v4u*)(KDT + uidx * 8192 + dk * 64 + c8 * 8) = pack8(o);
            }
        }
        __syncthreads();
        {
            bf16x8 tf[4][2];
#pragma unroll
            for (int t = 0; t < 4; ++t)
#pragma unroll
                for (int ks = 0; ks < 2; ++ks) tf[t][ks] = *(const LAS bf16x8*)(L + L_TB + (16 * t + fr) * 144 + (32 * ks + 8 * fq) * 2);
            bf16x8 vb[2], kg[2];
#pragma unroll
            for (int ks = 0; ks < 2; ++ks) { vb[ks] = *(const LAS bf16x8*)(L + L_VBT + (16 * w + fr) * 144 + (32 * ks + 8 * fq) * 2); kg[ks] = *(const LAS bf16x8*)(L + L_KGT + (16 * w + fr) * 144 + (32 * ks + 8 * fq) * 2); }
#pragma unroll
            for (int t = 0; t < 4; ++t) {
                f32x4 cu = (f32x4){0.f, 0.f, 0.f, 0.f}, cwt = (f32x4){0.f, 0.f, 0.f, 0.f};
#pragma unroll
                for (int ks = 0; ks < 2; ++ks) { cu = mfma16(tf[t][ks], vb[ks], cu); cwt = mfma16(kg[ks], tf[t][ks], cwt); }
                v2u ou; ou.x = pk2(cu[0], cu[1]); ou.y = pk2(cu[2], cu[3]);
                *(GAS v2u*)(U + uidx * 8192 + w * 1024 + t * 256 + lane * 4) = ou;
                v2u ow; ow.x = pk2(cwt[0], cwt[1]); ow.y = pk2(cwt[2], cwt[3]);
                *(GAS v2u*)(WP + uidx * 8192 + (16 * t + fr) * 128 + 32 * (w >> 1) + 8 * fq + 4 * (w & 1)) = ow;
            }
        }
        __syncthreads();
    }
}
constexpr int SC_W = 0, SC_QD = 17408, SC_KDT = 34816, SC_AQK = 53248, SC_BUF = 62464;
__device__ __forceinline__ void scan_phase(Frame& F, const Args& a, int bh) {
    const int b = bh >> 3, h = bh & 7; const int lane = F.lane, w = F.wave, fr = lane & 15, fq = lane >> 4, tid = F.tid;
    const bf16* U = actp<bf16>(F, A_U) + (size_t)bh * NCH * 8192; const bf16* WP = actp<bf16>(F, A_WP) + (size_t)bh * NCH * 8192;
    const bf16* QD = actp<bf16>(F, A_QD) + (size_t)bh * NCH * 8192; const bf16* KDT = actp<bf16>(F, A_KDT) + (size_t)bh * NCH * 8192; const bf16* AQK = actp<bf16>(F, A_AQK) + (size_t)bh * NCH * 4096;
    const bf16* Z = actp<bf16>(F, A_Z) + (size_t)b * T * 1024 + h * 128 + 16 * w + fr; bf16* OG = actp<bf16>(F, A_OG) + (size_t)b * T * 1024 + h * 128 + 16 * w + fr;
    const float* DL = (const float*)(F.ws + WS_TOK + TOK_DL) + (size_t)bh * NCH;
    const float nw = a.in[5][16 * w + fr];
    LAS unsigned char* L = F.lds; LAS float* part = (LAS float*)(L + AUX_OFF);
    f32x4 S[8];
#pragma unroll
    for (int i = 0; i < 8; ++i) S[i] = (f32x4){0.f, 0.f, 0.f, 0.f};
    v4u pre[7]; v2u upre[4];
#define SC_LOAD(nn) do { const v4u* pw = (const v4u*)(WP + (size_t)(nn) * 8192), *pq = (const v4u*)(QD + (size_t)(nn) * 8192), *pk = (const v4u*)(KDT + (size_t)(nn) * 8192), *pa = (const v4u*)(AQK + (size_t)(nn) * 4096); \
        pre[0] = pw[tid]; pre[1] = pw[tid + 512]; pre[2] = pq[tid]; pre[3] = pq[tid + 512]; pre[4] = pk[tid]; pre[5] = pk[tid + 512]; pre[6] = pa[tid]; \
        const v2u* pu = (const v2u*)(U + (size_t)(nn) * 8192 + w * 1024); upre[0] = pu[lane]; upre[1] = pu[64 + lane]; upre[2] = pu[128 + lane]; upre[3] = pu[192 + lane]; } while (0)
#define SC_STORE(buf) do { LAS unsigned char* B_ = L + (buf) * SC_BUF; \
        *(LAS v4u*)(B_ + SC_W + (tid >> 4) * 272 + (tid & 15) * 16) = pre[0]; *(LAS v4u*)(B_ + SC_W + (32 + (tid >> 4)) * 272 + (tid & 15) * 16) = pre[1]; \
        *(LAS v4u*)(B_ + SC_QD + (tid >> 4) * 272 + (tid & 15) * 16) = pre[2]; *(LAS v4u*)(B_ + SC_QD + (32 + (tid >> 4)) * 272 + (tid & 15) * 16) = pre[3]; \
        *(LAS v4u*)(B_ + SC_KDT + (tid >> 3) * 144 + (tid & 7) * 16) = pre[4]; *(LAS v4u*)(B_ + SC_KDT + (64 + (tid >> 3)) * 144 + (tid & 7) * 16) = pre[5]; \
        *(LAS v4u*)(B_ + SC_AQK + (tid >> 3) * 144 + (tid & 7) * 16) = pre[6]; } while (0)
    SC_LOAD(0); SC_STORE(0);
    v2u ucur[4];
#pragma unroll
    for (int i = 0; i < 4; ++i) ucur[i] = upre[i];
    __syncthreads();
#pragma unroll 1
    for (int n = 0; n < NCH; ++n) {
        const int buf = n & 1; LAS unsigned char* Bp = L + buf * SC_BUF;
        if (n + 1 < NCH) SC_LOAD(n + 1);
        unsigned short zr[16];
#pragma unroll
        for (int mt = 0; mt < 4; ++mt)
#pragma unroll
            for (int r = 0; r < 4; ++r) zr[mt * 4 + r] = Z[(size_t)(n * 64 + 16 * mt + 4 * fq + r) * 1024];
        const float dl = DL[n];
        bf16x8 Sb[4];
#pragma unroll
        for (int ks = 0; ks < 4; ++ks) Sb[ks] = frag_from(S[2 * ks], S[2 * ks + 1]);
        f32x4 vn[4], O[4];
#pragma unroll
        for (int mt = 0; mt < 4; ++mt) {
            f32x4 p = (f32x4){0.f, 0.f, 0.f, 0.f}, o = (f32x4){0.f, 0.f, 0.f, 0.f};
#pragma unroll
            for (int ks = 0; ks < 4; ++ks) { const bf16x8 aw = *(const LAS bf16x8*)(Bp + SC_W + (16 * mt + fr) * 272 + (32 * ks + 8 * fq) * 2), aq = *(const LAS bf16x8*)(Bp + SC_QD + (16 * mt + fr) * 272 + (32 * ks + 8 * fq) * 2);
                p = mfma16(aw, Sb[ks], p); o = mfma16(aq, Sb[ks], o); }
            const v2u uu = ucur[mt];
            vn[mt] = (f32x4){bflo(uu.x) - p[0], bfhi(uu.x) - p[1], bflo(uu.y) - p[2], bfhi(uu.y) - p[3]}; O[mt] = o;
        }
        bf16x8 Vb[2];
#pragma unroll
        for (int ks = 0; ks < 2; ++ks) Vb[ks] = frag_from(vn[2 * ks], vn[2 * ks + 1]);
#pragma unroll
        for (int mt = 0; mt < 4; ++mt)
#pragma unroll
            for (int ks = 0; ks < 2; ++ks) { const bf16x8 aa = *(const LAS bf16x8*)(Bp + SC_AQK + (16 * mt + fr) * 144 + (32 * ks + 8 * fq) * 2); O[mt] = mfma16(aa, Vb[ks], O[mt]); }
#pragma unroll
        for (int mt = 0; mt < 8; ++mt) { f32x4 s = S[mt] * dl;
#pragma unroll
            for (int ks = 0; ks < 2; ++ks) { const bf16x8 ak = *(const LAS bf16x8*)(Bp + SC_KDT + (16 * mt + fr) * 144 + (32 * ks + 8 * fq) * 2); s = mfma16(ak, Vb[ks], s); }
            S[mt] = s; }
        LAS float* pp = part + buf * 512;
#pragma unroll
        for (int mt = 0; mt < 4; ++mt)
#pragma unroll
            for (int r = 0; r < 4; ++r) { float q = O[mt][r] * O[mt][r]; q += __shfl_xor(q, 1); q += __shfl_xor(q, 2); q += __shfl_xor(q, 4); q += __shfl_xor(q, 8);
                if (fr == 0) pp[w * 64 + 16 * mt + 4 * fq + r] = q; }
        if (n + 1 < NCH) SC_STORE(buf ^ 1);
        __syncthreads();
#pragma unroll
        for (int mt = 0; mt < 4; ++mt)
#pragma unroll
            for (int r = 0; r < 4; ++r) { const int tk = 16 * mt + 4 * fq + r; float q = 0.f;
#pragma unroll
                for (int ww = 0; ww < 8; ++ww) q += pp[ww * 64 + tk];
                const float rs = 1.f / sqrtf(q * (1.f / 128.f) + GDN_EPS); const float zz = bf2f(zr[mt * 4 + r]);
                const float val = O[mt][r] * rs * nw * (zz / (1.f + expf(-zz)));
                OG[(size_t)(n * 64 + tk) * 1024] = (bf16)f2bf(val); }
#pragma unroll
        for (int i = 0; i < 4; ++i) ucur[i] = upre[i];
    }
#undef SC_LOAD
#undef SC_STORE
}
constexpr int AT_K = 0, AT_VT = 27648, AT_VT_LD = 432, AT_BIAS = AUX_OFF, AT_SINK = AUX_OFF + 8192;
__device__ __forceinline__ void attn_phase(Frame& F, const Args& a) {
    const bf16* Q = actp<bf16>(F, A_Q1); const bf16* K = actp<bf16>(F, A_K1); const bf16* V = actp<bf16>(F, A_V1); bf16* OB = actp<bf16>(F, A_OB);
    LAS unsigned char* L = F.lds; LAS float* bias2 = (LAS float*)(L + AT_BIAS); LAS float* sink2 = (LAS float*)(L + AT_SINK);
    const int lane = F.lane, w = F.wave, fr = lane & 15, fq = lane >> 4, tid = F.tid;
    for (int i = tid; i < 16 * 128; i += 512) { const int hh = i >> 7, dist = i & 127; int bk = dist;
        if (dist >= 16) { bk = 16 + (int)(logf((float)dist / 16.f) / 2.0794415416798357f * 16.f); bk = bk < 31 ? bk : 31; }
        bias2[i] = a.in[11][bk * 16 + hh] * LOG2E; }
    if (tid < 16) sink2[tid] = a.in[9][tid] * LOG2E;
    __syncthreads();
    for (int u = F.vcu; u < BATCH * 2 * (T / 64); u += F.G) {
        const int b = u >> 8, kvh = (u >> 7) & 1, qt = u & 127, t0 = qt * 64, ts = t0 - 128;
        for (int p = tid; p < 1536; p += 512) { const int j = p >> 3, c = p & 7; v4u kv = (v4u){0u, 0u, 0u, 0u}, vv = (v4u){0u, 0u, 0u, 0u};
            if (ts + j >= 0) { const size_t row = (size_t)(b * T + ts + j) * 128 + kvh * 64 + 8 * c; kv = *(const GAS v4u*)(K + row); vv = *(const GAS v4u*)(V + row); }
            *(LAS v4u*)(L + AT_K + j * 144 + c * 16) = kv;
            LAS bf16* vt = (LAS bf16*)(L + AT_VT + (8 * c) * AT_VT_LD + j * 2);
            vt[0 * (AT_VT_LD / 2)] = (bf16)(vv.x & 0xffff); vt[1 * (AT_VT_LD / 2)] = (bf16)(vv.x >> 16); vt[2 * (AT_VT_LD / 2)] = (bf16)(vv.y & 0xffff); vt[3 * (AT_VT_LD / 2)] = (bf16)(vv.y >> 16);
            vt[4 * (AT_VT_LD / 2)] = (bf16)(vv.z & 0xffff); vt[5 * (AT_VT_LD / 2)] = (bf16)(vv.z >> 16); vt[6 * (AT_VT_LD / 2)] = (bf16)(vv.w & 0xffff); vt[7 * (AT_VT_LD / 2)] = (bf16)(vv.w >> 16); }
        for (int p = tid; p < 64 * 16; p += 512) { const int d = p >> 4, j = 192 + (p & 15); *(LAS bf16*)(L + AT_VT + d * AT_VT_LD + j * 2) = 0; }
        __syncthreads();
        const int h = kvh * 8 + w; const float sk = sink2[h];
#pragma unroll 1
        for (int mt = 0; mt < 4; ++mt) {
            bf16x8 qf[2];
#pragma unroll
            for (int ks = 0; ks < 2; ++ks) qf[ks] = *(const GAS bf16x8*)(Q + (size_t)(b * T + t0 + 16 * mt + fr) * 1024 + h * 64 + 32 * ks + 8 * fq);
            f32x4 s[10]; float mx = sk;
#pragma unroll
            for (int nl = 0; nl < 10; ++nl) {
                f32x4 c = (f32x4){0.f, 0.f, 0.f, 0.f}; const int nt = mt + nl;
                if (nt < 12) {
#pragma unroll
                    for (int ks = 0; ks < 2; ++ks) { const bf16x8 kf = *(const LAS bf16x8*)(L + AT_K + (16 * nt + fr) * 144 + (32 * ks + 8 * fq) * 2); c = mfma16(kf, qf[ks], c); }
                }
#pragma unroll
                for (int r = 0; r < 4; ++r) { const int dist = 128 - 16 * nl + fr - 4 * fq - r, j = 16 * nt + 4 * fq + r;
                    const bool ok = (dist >= 0) && (dist < 128) && (ts + j >= 0) && (nt < 12);
                    const float v = ok ? c[r] + bias2[h * 128 + (dist & 127)] : -INFINITY; c[r] = v; mx = fmaxf(mx, v); }
                s[nl] = c;
            }
            mx = fmaxf(mx, __shfl_xor(mx, 16)); mx = fmaxf(mx, __shfl_xor(mx, 32));
            float sum = 0.f;
#pragma unroll
            for (int nl = 0; nl < 10; ++nl)
#pragma unroll
                for (int r = 0; r < 4; ++r) { const float p = __builtin_amdgcn_exp2f(s[nl][r] - mx); s[nl][r] = p; sum += p; }
            sum += __shfl_xor(sum, 16); sum += __shfl_xor(sum, 32);
            sum += __builtin_amdgcn_exp2f(sk - mx);
            const float inv = 1.f / sum;
            bf16x8 pb[5];
#pragma unroll
            for (int kk = 0; kk < 5; ++kk) pb[kk] = frag_from(s[2 * kk], s[2 * kk + 1]);
#pragma unroll
            for (int dt = 0; dt < 4; ++dt) {
                f32x4 o = (f32x4){0.f, 0.f, 0.f, 0.f};
#pragma unroll
                for (int kk = 0; kk < 5; ++kk) { const LAS unsigned char* vp = L + AT_VT + (16 * dt + fr) * AT_VT_LD + (16 * (mt + 2 * kk) + 4 * fq) * 2;
                    const v2u lo = *(const LAS v2u*)vp, hi = *(const LAS v2u*)(vp + 32); v4u av; av.x = lo.x; av.y = lo.y; av.z = hi.x; av.w = hi.y;
                    o = mfma16(__builtin_bit_cast(bf16x8, av), pb[kk], o); }
                v2u ov; ov.x = pk2(o[0] * inv, o[1] * inv); ov.y = pk2(o[2] * inv, o[3] * inv);
                *(GAS v2u*)(OB + (size_t)(b * T + t0 + 16 * mt + fr) * 1024 + h * 64 + 16 * dt + 4 * fq) = ov;
            }
        }
        __syncthreads();
    }
}
constexpr int N_PHASES = 19;
#ifndef MK_CUTS
#define MK_CUTS {0, N_PHASES}
#endif
__global__ void __launch_bounds__(NWAVES * 64, 2) hyb_fwd(Args args) {
    extern __shared__ __attribute__((aligned(16))) unsigned char lds[];
    Frame F;
    F.lds = (LAS unsigned char*)lds; F.MISC = (volatile LAS unsigned*)(F.lds + LDSCTL_OFF);
    F.tid = threadIdx.x; F.lane = F.tid & 63; F.wave = __builtin_amdgcn_readfirstlane(F.tid >> 6);
    F.G = gridDim.x; { const int bx = blockIdx.x; F.vcu = (F.G % 8 == 0) ? (bx % 8) * (F.G / 8) + bx / 8 : bx; }
    F.ws = args.ws; F.ctl = (gu32*)(args.ws + WS_CTL);
    for (int u = F.tid; u < 128; u += NWAVES * 64) ((LAS unsigned*)(F.lds + LDSCTL_OFF))[u] = 0u;
    __syncthreads();
    XcdBarrier bar = xcd_barrier_post((unsigned*)(F.ctl + CW_BAR) + args.li * XCD_BAR_WORDS, F.MISC + 8);
    const int lo = args.ph_lo, hi = args.ph_hi;
#ifndef PHMASK
#define PHMASK 0x7ffff
#endif
#define IN(k) ((((PHMASK) >> (k)) & 1) && lo <= (k) && (k) < hi)
#define SEAM(k) do { if (IN(k) && IN((k) + 1)) xcd_barrier(bar); } while (0)
    LAS unsigned char* ring = F.lds;
    const int bx = (int)blockIdx.x;

    if (IN(0)) { p0_prologue(F, args); } SEAM(0);
    if (IN(1)) {
        pg8::Gemm g{(const bf16*)args.out, (const bf16*)(F.ws + WS_W0T), M, 3072, D}; pg8::StaticOrder S; S.init(M, 3072, F.G, bx);
        pg8::EpiBf16<0> E{actp<bf16>(F, A_QK), D, nullptr, D, (size_t)M * D, 1.f};
        pg8::gemm_phase<pg8::EpiBf16<0>, pg8::StaticOrder, true, true>(ring, g, S, E);
    } SEAM(1);
    if (IN(2)) { cl_phase(F, args); } SEAM(2);
    if (IN(3)) {
        if (bx < 16) scan_phase(F, args, bx);
        else moe_weight_copies(F, args, (bx - 16) * NWAVES + F.wave, (F.G - 16) * NWAVES);
    } SEAM(3);
    if (IN(4)) {
        pg8::Gemm g{actp<bf16>(F, A_OG), (const bf16*)(F.ws + WS_WO0T), M, D, D}; pg8::StaticOrder S; S.init(M, D, F.G, bx);
        pg8::EpiResF32 E{actp<float>(F, A_H), args.in[0], D, ALPHA};
        pg8::gemm_phase<pg8::EpiResF32, pg8::StaticOrder, true, true>(ring, g, S, E);
    } SEAM(4);
    if (IN(5)) { ln_phase(F, actp<float>(F, A_H), args.in[19], args.in[20], actp<float>(F, A_X), actp<bf16>(F, A_XB)); } SEAM(5);
    if (IN(6)) {
        pg8::Gemm g{actp<bf16>(F, A_XB), (const bf16*)(F.ws + WS_WGU0T), M, 2 * FF, D}; pg8::StaticOrder S; S.init(M, 2 * FF, F.G, bx);
        pg8::EpiSwiglu E{actp<bf16>(F, A_HACT), FF, 1 << 20, 0};
        pg8::gemm_phase<pg8::EpiSwiglu, pg8::StaticOrder, true, true>(ring, g, S, E);
    } SEAM(6);
    if (IN(7)) {
        pg8::Gemm g{actp<bf16>(F, A_HACT), (const bf16*)(F.ws + WS_WD0T), M, D, FF}; pg8::StaticOrder S; S.init(M, D, F.G, bx);
        pg8::EpiResF32 E{actp<float>(F, A_H), actp<float>(F, A_X), D, ALPHA};
        pg8::gemm_phase<pg8::EpiResF32, pg8::StaticOrder, true, true>(ring, g, S, E);
    } SEAM(7);
    if (IN(8)) { ln_phase(F, actp<float>(F, A_H), args.in[19] + D, args.in[20] + D, actp<float>(F, A_X), actp<bf16>(F, A_XB)); } SEAM(8);
    if (IN(9)) {
        pg8::Gemm g{actp<bf16>(F, A_XB), (const bf16*)(F.ws + WS_W1T), M, 1280, D}; pg8::StaticOrder S; S.init(M, 1280, F.G, bx);
        pg8::EpiQKV1 E{actp<bf16>(F, A_Q1), actp<bf16>(F, A_K1), actp<bf16>(F, A_V1), args.in[8], 0.125f * LOG2E};
        pg8::gemm_phase<pg8::EpiQKV1, pg8::StaticOrder, true, true>(ring, g, S, E);
    } SEAM(9);
    if (IN(10)) { attn_phase(F, args); } SEAM(10);
    if (IN(11)) {
        pg8::Gemm g{actp<bf16>(F, A_OB), (const bf16*)(F.ws + WS_WO1T), M, D, D}; pg8::StaticOrder S; S.init(M, D, F.G, bx);
        pg8::EpiResF32 E{actp<float>(F, A_H), actp<float>(F, A_X), D, ALPHA};
        pg8::gemm_phase<pg8::EpiResF32, pg8::StaticOrder, true, true>(ring, g, S, E);
    } SEAM(11);
    if (IN(12)) { ln3_router_phase(F, args); } SEAM(12);
    if (IN(13)) { gather_phase(F); } SEAM(13);
#define MOE_UP(ph, pass) if (IN(ph)) { LAS int* off = (LAS int*)(F.lds + AUX_OFF); LAS int* tile_e = off + 16; moe_offsets(F, off, tile_e); \
        const int nT = off[8] >> 8, t_lo = (pass) * MOE_PASS_T < nT ? (pass) * MOE_PASS_T : nT, t_hi = ((pass) + 1) * MOE_PASS_T < nT ? ((pass) + 1) * MOE_PASS_T : nT; \
        pg8::Gemm g{actp<bf16>(F, A_XG), (const bf16*)(F.ws + WS_WGUT), 0, 0, D}; MoeOrder S; S.init(t_lo, t_hi, 28, F.G, bx, tile_e); \
        pg8::EpiSwiglu E{actp<bf16>(F, A_HACT2), ED, 28, t_lo}; \
        pg8::gemm_phase<pg8::EpiSwiglu, MoeOrder, true, true>(ring, g, S, E); }
#define MOE_DOWN(ph, pass) if (IN(ph)) { LAS int* off = (LAS int*)(F.lds + AUX_OFF); LAS int* tile_e = off + 16; moe_offsets(F, off, tile_e); \
        const int nT = off[8] >> 8, t_lo = (pass) * MOE_PASS_T < nT ? (pass) * MOE_PASS_T : nT, t_hi = ((pass) + 1) * MOE_PASS_T < nT ? ((pass) + 1) * MOE_PASS_T : nT; \
        pg8::Gemm g{actp<bf16>(F, A_HACT2) - (size_t)t_lo * 256 * ED, (const bf16*)(F.ws + WS_WDT), 0, 0, ED}; MoeOrder S; S.init(t_lo, t_hi, 4, F.G, bx, tile_e); \
        pg8::EpiMoeOut E{actp<bf16>(F, A_Y), D, 4, 0}; \
        pg8::gemm_phase<pg8::EpiMoeOut, MoeOrder, true, true>(ring, g, S, E); }
    MOE_UP(14, 0) SEAM(14);
    MOE_DOWN(15, 0) SEAM(15);
    MOE_UP(16, 1) SEAM(16);
    MOE_DOWN(17, 1) SEAM(17);
    if (IN(18)) { final_phase(F, args); }
#undef IN
#undef SEAM
}

extern "C" void kernel_launch(void* const* d_in, const int* in_sizes, int n_in, void* d_out, int out_size, void* d_ws, size_t ws_size, hipStream_t stream) {
    static int grid = 0;
    if (grid == 0) {
        if (n_in != 21 || out_size != M * D || ws_size < WS_END) { fprintf(stderr, "kernel_launch: unexpected shapes (n_in %d, out %d, ws %zu)\n", n_in, out_size, ws_size); grid = -1; return; }
        int dev = 0, cus = 0, per_cu = 0;
        if (hipGetDevice(&dev) != hipSuccess || hipDeviceGetAttribute(&cus, hipDeviceAttributeMultiprocessorCount, dev) != hipSuccess) { grid = -1; return; }
        if (hipFuncSetAttribute((const void*)hyb_fwd, hipFuncAttributeMaxDynamicSharedMemorySize, LDS_BYTES) != hipSuccess) { fprintf(stderr, "kernel_launch: hipFuncSetAttribute failed\n"); grid = -1; return; }
        if (hipOccupancyMaxActiveBlocksPerMultiprocessor(&per_cu, (const void*)hyb_fwd, NWAVES * 64, LDS_BYTES) != hipSuccess || per_cu < 1) fprintf(stderr, "kernel_launch: occupancy query reports %d\n", per_cu);
        (void)hipGetLastError();
        grid = cus;
    }
    if (grid < 0) return;
    (void)hipMemsetAsync((char*)d_ws + WS_CTL, 0, CTL_ZERO_BYTES, stream);
    Args a{};
    for (int i = 0; i < 21; ++i) a.in[i] = (const float*)d_in[i];
    a.out = (float*)d_out; a.ws = (unsigned char*)d_ws; a.dbg = 0;
    const int cuts[] = MK_CUTS; const int ncut = (int)(sizeof(cuts) / sizeof(cuts[0]));
    for (int li = 0; li + 1 < ncut; ++li) {
        a.ph_lo = cuts[li]; a.ph_hi = cuts[li + 1]; a.li = li;
        hipLaunchKernelGGL(hyb_fwd, dim3(grid), dim3(NWAVES * 64), LDS_BYTES, stream, a);
    }
}
```

```cpp
#include <hip/hip_runtime.h>
#include <cstdio>
#include <cstdint>
namespace pg8 {
#define PG8_LAS __attribute__((address_space(3)))
typedef unsigned short bf16_t;
typedef short bf16x8 __attribute__((ext_vector_type(8)));
typedef float f32x4 __attribute__((ext_vector_type(4)));
typedef unsigned u32x4 __attribute__((ext_vector_type(4)));
constexpr int BM = 256, BK = 64, HALF = 128, HTB = HALF * BK * 2  , STAGE_BYTES = 8 * HTB, NXCD = 8, WGM = 8;

__host__ __device__ __forceinline__ int lds_byte(int r, int c) { const int st = (r >> 4) * 2 + (c >> 5), rr = r & 15, cc = c & 31, ob = rr * 64 + cc * 2; return st * 1024 + (ob ^ (((ob >> 9) & 1) << 5)); }
__host__ __device__ __forceinline__ void stage_rc(int b, int& R, int& C) { const int st = b / 1024, sb = b % 1024, swz = sb ^ (((sb >> 9) & 1) << 5); R = (st >> 1) * 16 + swz / 64; C = (st & 1) * 32 + (swz % 64) / 2; }
__host__ __device__ __forceinline__ int perm32(int rho) { const int n = rho >> 4, i = rho & 15; return 8 * (i >> 2) + 4 * n + (i & 3); }

struct Unit { int pm, pn; };
struct Gemm { const bf16_t* A; const bf16_t* Bt; int M, N, K; };

struct StaticOrder {
    int nM, nN, nwg, G, c;
    __host__ __device__ void init(int M, int N, int G_, int c_) { nM = M / BM; nN = N / BM; nwg = nM * nN; G = G_; c = c_; }
    __host__ __device__ bool next(int i, Unit& u) const {
        const long L = (long)i * G + c; if (L >= nwg) return false;
        int wgid = (int)L; { const int q = nwg / NXCD, r = nwg % NXCD, xcd = wgid % NXCD, off = wgid / NXCD; wgid = (xcd < r ? xcd * (q + 1) : r * (q + 1) + (xcd - r) * q) + off; }
        const int nig = WGM * nN, gid = wgid / nig, fm = gid * WGM, gsz = (nM - fm) < WGM ? (nM - fm) : WGM;
        u.pm = fm + ((wgid % nig) % gsz); u.pn = (wgid % nig) / gsz; return true;
    }
    __device__ __forceinline__ void a_ready(const Unit&) const {}
    __device__ __forceinline__ void done(const Unit&) const {}
};

__device__ __forceinline__ unsigned cvt_pk_bf16(float lo, float hi) { unsigned r; asm volatile("v_cvt_pk_bf16_f32 %0, %1, %2" : "=v"(r) : "v"(lo), "v"(hi)); return r; }
typedef float f32x2 __attribute__((ext_vector_type(2)));
template <int ACT  > struct EpiBf16 {
    static constexpr bool PERM = true, AFTER_DRAIN = false; static_assert(ACT == 0, "EpiBf16: ACT is 0");
    bf16_t* O; int ldc; const float* bias; int split_cols; size_t split_stride; float scale0;
    __device__ __forceinline__ void operator()(const f32x4 (&acc)[2][2][4][2], const Unit& u, int wr, int wc, int fr, int fq) const {
        const int row0 = u.pm * BM + wr * 64 + fr; int colt = u.pn * BM; bf16_t* base = O;
        float sc = 1.f; if (split_cols) { const int t = colt / split_cols; base += (size_t)t * split_stride; colt -= t * split_cols; if (t == 0) sc = scale0; }
        const int col0 = colt + wc * 32 + 8 * fq, bcol0 = u.pn * BM + wc * 32 + 8 * fq;
        f32x4 bv[2][2];
#pragma unroll
        for (int bj = 0; bj < 2; ++bj)
#pragma unroll
            for (int n = 0; n < 2; ++n) bv[bj][n] = bias ? *(const f32x4*)(bias + bcol0 + bj * HALF + 4 * n) : (f32x4){0.f, 0.f, 0.f, 0.f};
#pragma unroll
        for (int ai = 0; ai < 2; ++ai)
#pragma unroll
            for (int m = 0; m < 4; ++m) { bf16_t* rowp = base + (size_t)(row0 + ai * HALF + m * 16) * ldc + col0;
#pragma unroll
                for (int bj = 0; bj < 2; ++bj) { f32x4 v0 = acc[ai][bj][m][0] + bv[bj][0], v1 = acc[ai][bj][m][1] + bv[bj][1];
                    v0 = v0 * sc; v1 = v1 * sc; u32x4 w; w.x = cvt_pk_bf16(v0[0], v0[1]); w.y = cvt_pk_bf16(v0[2], v0[3]); w.z = cvt_pk_bf16(v1[0], v1[1]); w.w = cvt_pk_bf16(v1[2], v1[3]);
                    *(u32x4*)(rowp + bj * HALF) = w; } }
    }
};
__device__ __forceinline__ float fast_silu(float x) { return x * __builtin_amdgcn_rcpf(1.0f + __builtin_amdgcn_exp2f(-1.4426950408889634f * x)); }
struct EpiResF32 {
    static constexpr bool PERM = false, AFTER_DRAIN = false;
    float* C; const float* res; int ldc; float alpha;
    __device__ __forceinline__ void operator()(const f32x4 (&acc)[2][2][4][2], const Unit& u, int wr, int wc, int fr, int fq) const {
        const int row0 = u.pm * BM + wr * 64 + fr, col0 = u.pn * BM + wc * 32 + 4 * fq;
#pragma unroll
        for (int ai = 0; ai < 2; ++ai)
#pragma unroll
            for (int m = 0; m < 4; ++m) { const size_t off = (size_t)(row0 + ai * HALF + m * 16) * ldc + col0;
#pragma unroll
                for (int bj = 0; bj < 2; ++bj)
#pragma unroll
                    for (int n = 0; n < 2; ++n) { const f32x4 r = *(const f32x4*)(res + off + bj * HALF + n * 16); *(f32x4*)(C + off + bj * HALF + n * 16) = r * alpha + acc[ai][bj][m][n]; } }
    }
};
struct EpiSwiglu {
    static constexpr bool PERM = true, AFTER_DRAIN = false;
    bf16_t* O; int ldc; int nN; int pm_off;
    __device__ __forceinline__ void operator()(const f32x4 (&acc)[2][2][4][2], const Unit& u, int wr, int wc, int fr, int fq) const {
        const int row0 = (u.pm - pm_off) * BM + wr * 64 + fr, col0 = (u.pn % nN) * HALF + wc * 32 + 8 * fq;
#pragma unroll
        for (int ai = 0; ai < 2; ++ai)
#pragma unroll
            for (int m = 0; m < 4; ++m) { bf16_t* rowp = O + (size_t)(row0 + ai * HALF + m * 16) * ldc + col0;
                const f32x4 g0 = acc[ai][0][m][0], g1 = acc[ai][0][m][1], u0 = acc[ai][1][m][0], u1 = acc[ai][1][m][1];
                u32x4 w;
                w.x = cvt_pk_bf16(fast_silu(g0[0]) * u0[0], fast_silu(g0[1]) * u0[1]); w.y = cvt_pk_bf16(fast_silu(g0[2]) * u0[2], fast_silu(g0[3]) * u0[3]);
                w.z = cvt_pk_bf16(fast_silu(g1[0]) * u1[0], fast_silu(g1[1]) * u1[1]); w.w = cvt_pk_bf16(fast_silu(g1[2]) * u1[2], fast_silu(g1[3]) * u1[3]);
                *(u32x4*)rowp = w; }
    }
};
struct EpiMoeOut {
    static constexpr bool PERM = true, AFTER_DRAIN = false;
    bf16_t* O; int ldc; int nN; int pm_off;
    __device__ __forceinline__ void operator()(const f32x4 (&acc)[2][2][4][2], const Unit& u, int wr, int wc, int fr, int fq) const {
        const int row0 = (u.pm - pm_off) * BM + wr * 64 + fr, col0 = (u.pn % nN) * BM + wc * 32 + 8 * fq;
#pragma unroll
        for (int ai = 0; ai < 2; ++ai)
#pragma unroll
            for (int m = 0; m < 4; ++m) { bf16_t* rowp = O + (size_t)(row0 + ai * HALF + m * 16) * ldc + col0;
#pragma unroll
                for (int bj = 0; bj < 2; ++bj) { const f32x4 v0 = acc[ai][bj][m][0], v1 = acc[ai][bj][m][1];
                    u32x4 w; w.x = cvt_pk_bf16(v0[0], v0[1]); w.y = cvt_pk_bf16(v0[2], v0[3]); w.z = cvt_pk_bf16(v1[0], v1[1]); w.w = cvt_pk_bf16(v1[2], v1[3]);
                    *(u32x4*)(rowp + bj * HALF) = w; } }
    }
};
struct EpiQKV1 {
    static constexpr bool PERM = true, AFTER_DRAIN = false;
    bf16_t* Q; bf16_t* Kb; bf16_t* Vb; const float* bias; float qscale;
    __device__ __forceinline__ void operator()(const f32x4 (&acc)[2][2][4][2], const Unit& u, int wr, int wc, int fr, int fq) const {
        const int row0 = u.pm * BM + wr * 64 + fr, cw = wc * 32 + 8 * fq, bcol0 = u.pn * BM + cw;
        const bool isq = u.pn < 4; const float sc = isq ? qscale : 1.f;
        f32x4 bv[2][2];
#pragma unroll
        for (int bj = 0; bj < 2; ++bj)
#pragma unroll
            for (int n = 0; n < 2; ++n) bv[bj][n] = *(const f32x4*)(bias + bcol0 + bj * HALF + 4 * n);
#pragma unroll
        for (int ai = 0; ai < 2; ++ai)
#pragma unroll
            for (int m = 0; m < 4; ++m) { const size_t row = (size_t)(row0 + ai * HALF + m * 16);
#pragma unroll
                for (int bj = 0; bj < 2; ++bj) { const f32x4 v0 = (acc[ai][bj][m][0] + bv[bj][0]) * sc, v1 = (acc[ai][bj][m][1] + bv[bj][1]) * sc;
                    u32x4 w; w.x = cvt_pk_bf16(v0[0], v0[1]); w.y = cvt_pk_bf16(v0[2], v0[3]); w.z = cvt_pk_bf16(v1[0], v1[1]); w.w = cvt_pk_bf16(v1[2], v1[3]);
                    bf16_t* dst = isq ? (Q + row * 1024 + u.pn * BM + bj * HALF + cw) : ((bj == 0 ? Kb : Vb) + row * 128 + cw);
                    *(u32x4*)dst = w; } }
    }
};
template <class Epi, class Sched, bool ALIGN_EPI = false, bool SP2 = false>
__device__ __forceinline__ void gemm_phase(PG8_LAS unsigned char* lds, const Gemm g, const Sched& S, const Epi& E) {
    const int tid = threadIdx.x, wid = __builtin_amdgcn_readfirstlane(tid >> 6), lane = tid & 63, wr = wid >> 2, wc = wid & 3, fr = lane & 15, fq = lane >> 4;
    const int K = g.K, nt = K / BK;
    unsigned voffA[2], voffB[2];
#pragma unroll
    for (int i = 0; i < 2; ++i) { int R, C; stage_rc(tid * 16 + i * 8192, R, C); const int Rb = Epi::PERM ? ((R & ~31) + perm32(R & 31)) : R;
        voffA[i] = (unsigned)(R * K + C) * 2u; voffB[i] = (unsigned)(Rb * K + C) * 2u; }
    const size_t kstep = (size_t)(BK * 2);
    const size_t hstep = (size_t)HALF * K * 2;
    const size_t tstep = 2 * hstep;
    const unsigned ldsw = (unsigned)wid * 1024u;
    const int aoff = lds_byte(wr * 64 + fr, fq * 8), boff = lds_byte(wc * 32 + fr, fq * 8);
#define PG8_SA(b, h) (((b) * 2 + (h)) * HTB)
#define PG8_SB(b, h) ((4 + (b) * 2 + (h)) * HTB)
#define PG8_STAGE(bufoff, gbase, voff) do { _Pragma("unroll") for (int _i = 0; _i < 2; ++_i) \
        __builtin_amdgcn_global_load_lds((const unsigned*)((const char*)(gbase) + (voff)[_i]), (PG8_LAS unsigned*)(lds + (bufoff) + ldsw + _i * 8192), 16, 0, 0); } while (0)
#define PG8_LDA(dst, b, h) do { _Pragma("unroll") for (int m = 0; m < 4; ++m) _Pragma("unroll") for (int k = 0; k < 2; ++k) dst[m][k] = *(const PG8_LAS bf16x8*)(lds + PG8_SA(b, h) + aoff + m * 2048 + k * 1024); } while (0)
#define PG8_LDB(dst, b, h) do { _Pragma("unroll") for (int n = 0; n < 2; ++n) _Pragma("unroll") for (int k = 0; k < 2; ++k) dst[n][k] = *(const PG8_LAS bf16x8*)(lds + PG8_SB(b, h) + boff + n * 2048 + k * 1024); } while (0)
#define PG8_MMA(ai, bj, At, Bt) do { __builtin_amdgcn_s_setprio(1); _Pragma("unroll") for (int m = 0; m < 4; ++m) _Pragma("unroll") for (int n = 0; n < 2; ++n) _Pragma("unroll") for (int k = 0; k < 2; ++k) \
        acc[ai][bj][m][n] = __builtin_amdgcn_mfma_f32_16x16x32_bf16(Bt[n][k], At[m][k], acc[ai][bj][m][n], 0, 0, 0); __builtin_amdgcn_s_setprio(0); } while (0)
#define PG8_WAIT_V(n) asm volatile("s_waitcnt vmcnt(" #n ")" ::: "memory")
#define PG8_WAIT_L(n) asm volatile("s_waitcnt lgkmcnt(" #n ")" ::: "memory")
#define PG8_BAR __builtin_amdgcn_s_barrier()
#define PG8_SCHED __builtin_amdgcn_sched_barrier(0)
    Unit cur, nxt; int ui = 0;
    if (!S.next(0, cur)) return;
    f32x4 acc[2][2][4][2];
#pragma unroll
    for (int a = 0; a < 2; ++a)
#pragma unroll
        for (int b = 0; b < 2; ++b)
#pragma unroll
            for (int m = 0; m < 4; ++m)
#pragma unroll
                for (int n = 0; n < 2; ++n) acc[a][b][m][n] = (f32x4){0.f, 0.f, 0.f, 0.f};
    bf16x8 At[4][2], B0[2][2], B1[2][2];
    const char* cA = (const char*)g.A + (size_t)cur.pm * tstep; const char* cB = (const char*)g.Bt + (size_t)cur.pn * tstep;
    S.a_ready(cur);
    if constexpr (SP2) {
        PG8_STAGE(PG8_SB(0, 0), cB, voffB); PG8_STAGE(PG8_SB(0, 1), cB + hstep, voffB); PG8_STAGE(PG8_SA(0, 0), cA, voffA); PG8_STAGE(PG8_SA(0, 1), cA + hstep, voffA);
        if (wr == 1) PG8_BAR;
        PG8_WAIT_V(2); PG8_BAR;
        PG8_STAGE(PG8_SB(1, 0), cB + kstep, voffB); PG8_STAGE(PG8_SA(1, 0), cA + kstep, voffA); PG8_STAGE(PG8_SB(1, 1), cB + hstep + kstep, voffB);
        PG8_WAIT_V(6); PG8_BAR;
    } else {
        PG8_STAGE(PG8_SB(0, 0), cB, voffB); PG8_STAGE(PG8_SA(0, 0), cA, voffA); PG8_STAGE(PG8_SB(0, 1), cB + hstep, voffB); PG8_STAGE(PG8_SA(0, 1), cA + hstep, voffA);
        if (wr == 1) PG8_BAR;
        PG8_WAIT_V(4); PG8_BAR;
        PG8_STAGE(PG8_SB(1, 0), cB + kstep, voffB); PG8_STAGE(PG8_SA(1, 0), cA + kstep, voffA); PG8_STAGE(PG8_SB(1, 1), cB + hstep + kstep, voffB);
        PG8_WAIT_V(6); PG8_BAR;
    }
    for (;;) {
        const bool has_next = S.next(ui + 1, nxt);
        const char* nA = has_next ? (const char*)g.A + (size_t)nxt.pm * tstep : cA; const char* nB = has_next ? (const char*)g.Bt + (size_t)nxt.pn * tstep : cB;
        for (int t = 0; t < nt; t += 2) {
            const bool last = (t == nt - 2);
            const char* a1 = cA + (size_t)(t + 1) * kstep;
            const char* a2 = last ? nA : cA + (size_t)(t + 2) * kstep; const char* b2 = last ? nB : cB + (size_t)(t + 2) * kstep;
            const char* a3 = a2 + kstep; const char* b3 = b2 + kstep;
            if (last && has_next) S.a_ready(nxt);
            if constexpr (SP2) {
            PG8_LDB(B0, 0, 0); PG8_LDB(B1, 0, 1); PG8_SCHED; PG8_LDA(At, 0, 0); PG8_STAGE(PG8_SA(1, 1), a1 + hstep, voffA);
            PG8_WAIT_V(8); PG8_WAIT_L(0); PG8_BAR; PG8_MMA(0, 0, At, B0); PG8_MMA(0, 1, At, B1); PG8_BAR; PG8_SCHED;
            PG8_LDA(At, 0, 1); PG8_STAGE(PG8_SB(0, 0), b2, voffB); PG8_STAGE(PG8_SB(0, 1), b2 + hstep, voffB); PG8_STAGE(PG8_SA(0, 0), a2, voffA);
            PG8_WAIT_V(8); PG8_WAIT_L(0); PG8_BAR; PG8_MMA(1, 0, At, B0); PG8_MMA(1, 1, At, B1); PG8_BAR; PG8_SCHED;
            PG8_LDB(B0, 1, 0); PG8_LDB(B1, 1, 1); PG8_SCHED; PG8_LDA(At, 1, 0); PG8_STAGE(PG8_SA(0, 1), a2 + hstep, voffA);
            PG8_WAIT_V(8); PG8_WAIT_L(0); PG8_BAR; PG8_MMA(0, 0, At, B0); PG8_MMA(0, 1, At, B1); PG8_BAR; PG8_SCHED;
            PG8_LDA(At, 1, 1); PG8_STAGE(PG8_SB(1, 0), b3, voffB); PG8_STAGE(PG8_SB(1, 1), b3 + hstep, voffB); PG8_STAGE(PG8_SA(1, 0), a3, voffA);
            PG8_WAIT_V(8); PG8_WAIT_L(0); PG8_BAR; PG8_MMA(1, 0, At, B0); PG8_MMA(1, 1, At, B1); PG8_BAR; PG8_SCHED;
            } else {
            PG8_LDB(B0, 0, 0); PG8_SCHED; PG8_LDA(At, 0, 0); PG8_STAGE(PG8_SA(1, 1), a1 + hstep, voffA);
            PG8_WAIT_L(8); PG8_BAR; PG8_WAIT_L(0); PG8_MMA(0, 0, At, B0); PG8_BAR; PG8_SCHED;
            PG8_LDB(B1, 0, 1); PG8_STAGE(PG8_SB(0, 0), b2, voffB);
            PG8_BAR; PG8_WAIT_L(0); PG8_MMA(0, 1, At, B1); PG8_BAR;
            PG8_LDA(At, 0, 1); PG8_STAGE(PG8_SA(0, 0), a2, voffA);
            PG8_BAR; PG8_WAIT_L(0); PG8_MMA(1, 0, At, B0); PG8_BAR; PG8_SCHED;
            PG8_STAGE(PG8_SB(0, 1), b2 + hstep, voffB);
            PG8_WAIT_V(6); PG8_BAR; PG8_MMA(1, 1, At, B1); PG8_BAR;
            PG8_LDB(B0, 1, 0); PG8_SCHED; PG8_LDA(At, 1, 0); PG8_STAGE(PG8_SA(0, 1), a2 + hstep, voffA);
            PG8_WAIT_L(8); PG8_BAR; PG8_WAIT_L(0); PG8_MMA(0, 0, At, B0); PG8_BAR; PG8_SCHED;
            PG8_LDB(B1, 1, 1); PG8_STAGE(PG8_SB(1, 0), b3, voffB);
            PG8_BAR; PG8_WAIT_L(0); PG8_MMA(0, 1, At, B1); PG8_BAR;
            PG8_LDA(At, 1, 1); PG8_STAGE(PG8_SA(1, 0), a3, voffA);
            PG8_BAR; PG8_WAIT_L(0); PG8_MMA(1, 0, At, B0); PG8_BAR; PG8_SCHED;
            PG8_STAGE(PG8_SB(1, 1), b3 + hstep, voffB);
            PG8_WAIT_V(6); PG8_BAR; PG8_MMA(1, 1, At, B1); PG8_BAR;
            }
        }
        if constexpr (ALIGN_EPI) { if (wr == 0) PG8_BAR; }
        if constexpr (!Epi::AFTER_DRAIN) { E(acc, cur, wr, wc, fr, fq); S.done(cur); }
        if (!has_next) break;
#pragma unroll
        for (int a = 0; a < 2; ++a)
#pragma unroll
            for (int b = 0; b < 2; ++b)
#pragma unroll
                for (int m = 0; m < 4; ++m)
#pragma unroll
                    for (int n = 0; n < 2; ++n) acc[a][b][m][n] = (f32x4){0.f, 0.f, 0.f, 0.f};
        cur = nxt; cA = nA; cB = nB; ++ui;
        if constexpr (ALIGN_EPI) { if (wr == 1) PG8_BAR; }
    }
    PG8_WAIT_V(0);
    if constexpr (!ALIGN_EPI) { if (wr == 0) PG8_BAR; }
    PG8_BAR;
    if constexpr (Epi::AFTER_DRAIN) { E.fused(acc, cur, wr, wc, fr, fq, lds, wid, lane); S.done(cur); }
#undef PG8_SA
#undef PG8_SB
#undef PG8_STAGE
#undef PG8_LDA
#undef PG8_LDB
#undef PG8_MMA
#undef PG8_WAIT_V
#undef PG8_WAIT_L
#undef PG8_BAR
#undef PG8_SCHED
}
}
constexpr int BATCH = 2, T = 8192, D = 1024, M = BATCH * T;
constexpr int GH = 8, CH = 64, NCH = T / CH;
constexpr int GIN = 3088, FF = 2816, NE = 8, ED = 3584;
constexpr float ALPHA = 1.4142135623730951f, LN_EPS = 1e-5f, GDN_EPS = 1e-6f, LOG2E = 1.4426950408889634f;
constexpr int NWAVES = 8;
constexpr size_t MiB = (size_t)1 << 20;
constexpr size_t WS_CTL = 0, CTL_ZERO_BYTES = 1 * MiB;
constexpr size_t WS_W0T = 1 * MiB, WS_WO0T = 7 * MiB, WS_WGU0T = 9 * MiB, WS_WD0T = 20 * MiB, WS_W1T = 26 * MiB, WS_WO1T = 29 * MiB;
constexpr size_t WS_ABLOG = 31 * MiB, WS_TOK = 32 * MiB;
constexpr size_t TOK_DL = 0, TOK_E = 64 * 1024, TOK_SLOT = 192 * 1024, TOK_W = 320 * 1024, TOK_ROW = 448 * 1024;
constexpr size_t WS_WGUT = 34 * MiB, WS_WDT = 146 * MiB, WS_ACT = 202 * MiB, WS_END = 458 * MiB;
constexpr size_t A_QK = 0, A_V = 32 * MiB, A_S = 0, A_Z = 64 * MiB, A_U = 96 * MiB, A_WP = 128 * MiB, A_QD = 160 * MiB, A_KDT = 192 * MiB, A_AQK = 224 * MiB, A_OG = 192 * MiB;
constexpr size_t A_H = 0, A_X = 64 * MiB, A_XB = 128 * MiB, A_HACT = 160 * MiB;
constexpr size_t A_Q1 = 160 * MiB, A_K1 = 192 * MiB, A_V1 = 196 * MiB, A_OB = 200 * MiB;
constexpr size_t A_XG = 0, A_Y = 68 * MiB, A_HACT2 = 136 * MiB;
constexpr int MOE_MAXT = 136;
constexpr int MOE_PASS_T = 68;
static_assert(A_HACT2 + (size_t)MOE_PASS_T * 256 * ED * 2 <= 256 * MiB, "act map");
constexpr int CW_TMO = 0, CW_CODE = 1, CW_BAR = 4096, CW_MOE = 131072, CW_DBG = 196608;
constexpr int RING_BYTES = 131072, AUX_OFF = 131072, AUX_BYTES = 24576, LDSCTL_OFF = AUX_OFF + AUX_BYTES, LDS_BYTES = LDSCTL_OFF + 512;

#define GAS __attribute__((address_space(1)))
#define LAS __attribute__((address_space(3)))
typedef unsigned short bf16;
typedef unsigned v4u __attribute__((ext_vector_type(4)));
typedef unsigned v2u __attribute__((ext_vector_type(2)));
typedef float f32x4 __attribute__((ext_vector_type(4)));
typedef short bf16x8 __attribute__((ext_vector_type(8)));
typedef GAS unsigned gu32;
#define RLX_AGENT __ATOMIC_RELAXED, __HIP_MEMORY_SCOPE_AGENT
#define LDS_WAIT() asm volatile("s_waitcnt lgkmcnt(0)" ::: "memory")
#define VM_WAIT() asm volatile("s_waitcnt vmcnt(0)" ::: "memory")
__device__ __forceinline__ unsigned f2bf(float f) { unsigned u = __builtin_bit_cast(unsigned, f); return (u + 0x7fffu + ((u >> 16) & 1u)) >> 16; }
__device__ __forceinline__ unsigned pk2(float lo, float hi) { return f2bf(lo) | (f2bf(hi) << 16); }
__device__ __forceinline__ float bf2f(unsigned b) { return __builtin_bit_cast(float, b << 16); }
__device__ __forceinline__ float bflo(unsigned w) { return __builtin_bit_cast(float, w << 16); }
__device__ __forceinline__ float bfhi(unsigned w) { return __builtin_bit_cast(float, w & 0xffff0000u); }
__device__ __forceinline__ void unpack8(const v4u v, float (&o)[8]) { o[0] = bflo(v.x); o[1] = bfhi(v.x); o[2] = bflo(v.y); o[3] = bfhi(v.y); o[4] = bflo(v.z); o[5] = bfhi(v.z); o[6] = bflo(v.w); o[7] = bfhi(v.w); }
__device__ __forceinline__ v4u pack8(const float (&o)[8]) { v4u v; v.x = pk2(o[0], o[1]); v.y = pk2(o[2], o[3]); v.z = pk2(o[4], o[5]); v.w = pk2(o[6], o[7]); return v; }
__device__ __forceinline__ f32x4 mfma16(bf16x8 a, bf16x8 b, f32x4 c) { return __builtin_amdgcn_mfma_f32_16x16x32_bf16(a, b, c, 0, 0, 0); }
__device__ __forceinline__ bf16x8 frag_from(const f32x4 lo, const f32x4 hi) {
    v4u v; v.x = pk2(lo[0], lo[1]); v.y = pk2(lo[2], lo[3]); v.z = pk2(hi[0], hi[1]); v.w = pk2(hi[2], hi[3]); return __builtin_bit_cast(bf16x8, v); }
__device__ __forceinline__ float wave_sum(float v) {
#pragma unroll
    for (int o = 1; o < 64; o <<= 1) v += __shfl_xor(v, o);
    return v;
}
__device__ __forceinline__ float rdlane(float v, int l) { return __builtin_bit_cast(float, __builtin_amdgcn_readlane(__builtin_bit_cast(int, v), l)); }

#define XB_TMO      128
#define XB_XCNT(j)  (256  + 64 * (j))
#define XB_XSUB(j)  (1280 + 64 * (j))
#define XB_XGEN(j)  (2304 + 64 * (j))
#define XB_TOP      3328
#define XB_TOPGEN   3392
#define XCD_BAR_WORDS 3456
#define XB_SPIN_CAP (1u << 18)

__device__ __forceinline__ unsigned xb_ld(unsigned* p)              { return __hip_atomic_load(p, __ATOMIC_RELAXED, __HIP_MEMORY_SCOPE_AGENT); }
__device__ __forceinline__ unsigned xb_add(unsigned* p, unsigned v) { return __hip_atomic_fetch_add(p, v, __ATOMIC_RELAXED, __HIP_MEMORY_SCOPE_AGENT); }
__device__ __forceinline__ unsigned xb_xcc_id() { return (unsigned)__builtin_amdgcn_s_getreg((3 << 11) | 20) & 0xFu; }
#define XB_SPIN(cond, bar) do { unsigned _sp = 0; while (cond) { __builtin_amdgcn_s_sleep(1); \
    if ((++_sp & 255u) == 0u) { if (xb_ld(&(bar)[XB_TMO])) break; if (_sp > XB_SPIN_CAP) { atomicAdd(&(bar)[XB_TMO], 1u); break; } } } } while (0)

struct XcdBarrier {
    unsigned* bar; unsigned x;
    volatile LAS unsigned* st;
};

__device__ __forceinline__ XcdBarrier xcd_barrier_post(unsigned* bar, volatile LAS unsigned* st) {
    XcdBarrier b; b.bar = bar; b.x = xb_xcc_id(); b.st = st;
    if (threadIdx.x == 0) (void)xb_add(&bar[XB_XCNT(b.x)], 1u);
    return b;
}
__device__ __forceinline__ void xcd_barrier_complete(unsigned* bar, unsigned x, unsigned& nloc, unsigned& nx) {
    const unsigned G = gridDim.x * gridDim.y * gridDim.z;
    unsigned sum, cnt, mine, sp = 0u;
    for (;;) {
        sum = 0u; cnt = 0u; mine = 0u;
#pragma unroll
        for (unsigned j = 0; j < 16; ++j) { const unsigned c = xb_ld(&bar[XB_XCNT(j)]); sum += c; cnt += (c > 0u) ? 1u : 0u; mine = (j == x) ? c : mine; }
        if (sum == G) break;
        __builtin_amdgcn_s_sleep(1);
        if ((++sp & 255u) == 0u) { if (xb_ld(&bar[XB_TMO])) break; if (sp > XB_SPIN_CAP) { atomicAdd(&bar[XB_TMO], 1u); break; } }
    }
    nloc = mine > 0u ? mine : 1u; nx = cnt > 0u ? cnt : 1u;
}

__device__ __forceinline__ void xcd_barrier(const XcdBarrier& b) {
    asm volatile("s_waitcnt vmcnt(0)" ::: "memory");
    __syncthreads();
    if (threadIdx.x == 0) {
        unsigned* bar = b.bar;
        __builtin_amdgcn_s_waitcnt(0);
        unsigned nloc = b.st[0], nx = b.st[1];
        if (nloc == 0u) { xcd_barrier_complete(bar, b.x, nloc, nx); b.st[0] = nloc; b.st[1] = nx; }
        const unsigned old = xb_add(&bar[XB_XSUB(b.x)], 1u);
        const unsigned gen = old / nloc;
        if (old + 1u == (gen + 1u) * nloc) {
            __builtin_amdgcn_fence(__ATOMIC_RELEASE, "agent");
            asm volatile("s_waitcnt vmcnt(0)" ::: "memory");
            const unsigned og = xb_add(&bar[XB_TOP], 1u);
            const unsigned tg = og / nx;
            if (og + 1u == (tg + 1u) * nx) xb_add(&bar[XB_TOPGEN], 1u);
            else XB_SPIN(xb_ld(&bar[XB_TOPGEN]) == tg, bar);
            __builtin_amdgcn_fence(__ATOMIC_ACQUIRE, "agent");
            xb_add(&bar[XB_XGEN(b.x)], 1u);
            asm volatile("s_waitcnt vmcnt(0)" ::: "memory");
        } else {
            XB_SPIN(xb_ld(&bar[XB_XGEN(b.x)]) == gen, bar);
            __builtin_amdgcn_fence(__ATOMIC_ACQUIRE, "agent");
            asm volatile("s_waitcnt vmcnt(0)" ::: "memory");
        }
    }
    __syncthreads();
}
struct Args { const float* in[21]; float* out; unsigned char* ws; int ph_lo, ph_hi, li, dbg; };
struct Frame {
    LAS unsigned char* lds; volatile LAS unsigned* MISC; gu32* ctl; unsigned char* ws;
    int tid, lane, wave, vcu, G;
};
template <class TT> __device__ __forceinline__ TT* actp(const Frame& F, size_t off) { return (TT*)(F.ws + WS_ACT + off); }

__device__ __forceinline__ void transpose_item(const float* W, int ldw, int nblk, bf16* WT, int ldt, int mode, int item, LAS float* scr, int lane) {
    const int kb = item / nblk, nb = item - kb * nblk, k0 = 64 * kb, n0 = 32 * nb;
    const int drow0 = mode == 0 ? n0 : ((n0 >> 7) * 256 + (n0 & 127) + (mode == 2 ? 128 : 0));
#pragma unroll 8
    for (int i = 0; i < 32; ++i) { const int kk = 2 * i + (lane >> 5); scr[kk * 33 + (lane & 31)] = W[(size_t)(k0 + kk) * ldw + n0 + (lane & 31)]; }
    LDS_WAIT(); asm volatile("" ::: "memory");
    const int c = lane & 7;
#pragma unroll
    for (int j = 0; j < 4; ++j) { const int n = (lane >> 3) + 8 * j; const LAS float* s = scr + (8 * c) * 33 + n;
        v4u o; o.x = pk2(s[0 * 33], s[1 * 33]); o.y = pk2(s[2 * 33], s[3 * 33]); o.z = pk2(s[4 * 33], s[5 * 33]); o.w = pk2(s[6 * 33], s[7 * 33]);
        *(GAS v4u*)(WT + (size_t)(drow0 + n) * ldt + k0 + 8 * c) = o; }
    LDS_WAIT(); asm volatile("" ::: "memory");
}
__device__ __forceinline__ void p0_prologue(Frame& F, const Args& a) {
    LAS float* scr = (LAS float*)(F.lds + F.wave * 16384);
    const int gw = F.vcu * NWAVES + F.wave, NGW = F.G * NWAVES;
    constexpr int I0 = 16 * 96, I1 = 16 * 32, I2 = 16 * 88, I3 = I2, I4 = 44 * 32, I5 = 16 * 40, I6 = 16 * 32, NIT = I0 + I1 + I2 + I3 + I4 + I5 + I6;
    unsigned char* ws = F.ws;
    for (int it = gw; it < NIT; it += NGW) {
        int r = it;
        if (r < I0) { transpose_item(a.in[1], GIN, 96, (bf16*)(ws + WS_W0T), D, 0, r, scr, F.lane); continue; } r -= I0;
        if (r < I1) { transpose_item(a.in[6], D, 32, (bf16*)(ws + WS_WO0T), D, 0, r, scr, F.lane); continue; } r -= I1;
        if (r < I2) { transpose_item(a.in[12], FF, 88, (bf16*)(ws + WS_WGU0T), D, 1, r, scr, F.lane); continue; } r -= I2;
        if (r < I3) { transpose_item(a.in[13], FF, 88, (bf16*)(ws + WS_WGU0T), D, 2, r, scr, F.lane); continue; } r -= I3;
        if (r < I4) { transpose_item(a.in[14], D, 32, (bf16*)(ws + WS_WD0T), FF, 0, r, scr, F.lane); continue; } r -= I4;
        if (r < I5) { transpose_item(a.in[7], 1280, 40, (bf16*)(ws + WS_W1T), D, 0, r, scr, F.lane); continue; } r -= I5;
        transpose_item(a.in[10], D, 32, (bf16*)(ws + WS_WO1T), D, 0, r, scr, F.lane);
    }
    { const GAS f32x4* xs = (const GAS f32x4*)a.in[0]; GAS v4u* xd = (GAS v4u*)a.out;
      const size_t n8 = (size_t)M * D / 8, gt = (size_t)F.vcu * 512 + F.tid, NT = (size_t)F.G * 512;
      for (size_t i = gt; i < n8; i += NT) { const f32x4 p = xs[2 * i], q = xs[2 * i + 1]; v4u o; o.x = pk2(p[0], p[1]); o.y = pk2(p[2], p[3]); o.z = pk2(q[0], q[1]); o.w = pk2(q[2], q[3]); xd[i] = o; } }
    __syncthreads();
    { LAS float* wl = (LAS float*)F.lds; const float* win = a.in[1];
      for (int i = F.tid; i < 1024 * 16; i += 512) { const int k = i >> 4, j = i & 15; wl[k * 20 + j] = win[(size_t)k * GIN + 3072 + j]; }
      __syncthreads();
      float* ablog = (float*)(ws + WS_ABLOG);
      for (int m = gw; m < M; m += NGW) {
          const float* xr = a.in[0] + (size_t)m * D;
          float acc[16];
#pragma unroll
          for (int j = 0; j < 16; ++j) acc[j] = 0.f;
#pragma unroll 4
          for (int i = 0; i < 16; ++i) { const int k = F.lane + 64 * i; const float xv = xr[k]; const LAS f32x4* wr = (const LAS f32x4*)(wl + k * 20);
#pragma unroll
              for (int q = 0; q < 4; ++q) { const f32x4 w = wr[q]; acc[4 * q] += xv * w[0]; acc[4 * q + 1] += xv * w[1]; acc[4 * q + 2] += xv * w[2]; acc[4 * q + 3] += xv * w[3]; } }
#pragma unroll
          for (int j = 0; j < 16; ++j) acc[j] = wave_sum(acc[j]);
          if (F.lane == 0) { GAS f32x4* o = (GAS f32x4*)(ablog + (size_t)m * 16);
              o[0] = (f32x4){acc[0], acc[1], acc[2], acc[3]}; o[1] = (f32x4){acc[4], acc[5], acc[6], acc[7]}; o[2] = (f32x4){acc[8], acc[9], acc[10], acc[11]}; o[3] = (f32x4){acc[12], acc[13], acc[14], acc[15]}; }
      }
      __syncthreads(); }
}
__device__ __forceinline__ void moe_weight_copies(Frame& F, const Args& a, int gw, int NGW) {
    LAS float* scr = (LAS float*)(F.lds + F.wave * 16384);
    constexpr int PER = 1792, NIT = NE * 3 * PER;
    for (int it = gw; it < NIT; it += NGW) {
        const int e = it / (3 * PER), r = it - e * 3 * PER, which = r / PER, item = r - which * PER;
        bf16* gu = (bf16*)(F.ws + WS_WGUT) + (size_t)e * 2 * ED * D; bf16* dn = (bf16*)(F.ws + WS_WDT) + (size_t)e * D * ED;
        if (which == 0) transpose_item(a.in[16] + (size_t)e * D * ED, ED, 112, gu, D, 1, item, scr, F.lane);
        else if (which == 1) transpose_item(a.in[17] + (size_t)e * D * ED, ED, 112, gu, D, 2, item, scr, F.lane);
        else transpose_item(a.in[18] + (size_t)e * ED * D, D, 32, dn, ED, 0, item, scr, F.lane);
    }
}

__device__ __forceinline__ void ln_core(f32x4 (&v)[4], const f32x4 (&g)[4], const f32x4 (&bb)[4]) {
    float s = 0.f;
#pragma unroll
    for (int j = 0; j < 4; ++j) s += (v[j][0] + v[j][1]) + (v[j][2] + v[j][3]);
    const float mean = wave_sum(s) * (1.f / D); float s2 = 0.f;
#pragma unroll
    for (int j = 0; j < 4; ++j) { v[j] = v[j] - mean; s2 += (v[j][0] * v[j][0] + v[j][1] * v[j][1]) + (v[j][2] * v[j][2] + v[j][3] * v[j][3]); }
    const float rstd = 1.f / sqrtf(wave_sum(s2) * (1.f / D) + LN_EPS);
#pragma unroll
    for (int j = 0; j < 4; ++j) v[j] = v[j] * rstd * g[j] + bb[j];
}
__device__ __forceinline__ void ln_phase(Frame& F, const float* src, const float* g, const float* b, float* dstf, bf16* dstb) {
    const int gw = F.vcu * NWAVES + F.wave, NGW = F.G * NWAVES;
    f32x4 gv[4], bv[4];
#pragma unroll
    for (int j = 0; j < 4; ++j) { gv[j] = ((const GAS f32x4*)g)[F.lane + 64 * j]; bv[j] = ((const GAS f32x4*)b)[F.lane + 64 * j]; }
    for (int m = gw; m < M; m += NGW) {
        const GAS f32x4* xr = (const GAS f32x4*)(src + (size_t)m * D) + F.lane; f32x4 v[4];
#pragma unroll
        for (int j = 0; j < 4; ++j) v[j] = xr[64 * j];
        ln_core(v, gv, bv);
        GAS f32x4* of = (GAS f32x4*)(dstf + (size_t)m * D) + F.lane; GAS v2u* ob = (GAS v2u*)(dstb + (size_t)m * D) + F.lane;
#pragma unroll
        for (int j = 0; j < 4; ++j) { of[64 * j] = v[j]; v2u o; o.x = pk2(v[j][0], v[j][1]); o.y = pk2(v[j][2], v[j][3]); ob[64 * j] = o; }
    }
}

__device__ __forceinline__ void ln3_router_phase(Frame& F, const Args& a) {
    const float* src = actp<float>(F, A_H); const float* g = a.in[19] + 2 * D; const float* b = a.in[20] + 2 * D;
    float* dstf = a.out; bf16* dstb = actp<bf16>(F, A_XB);
    LAS float* wrT = (LAS float*)F.lds;
    LAS int* lcnt = (LAS int*)(F.lds + AUX_OFF);
    for (int i = F.tid; i < 8192; i += 512) { const int k = i >> 3, e = i & 7; wrT[e * 1024 + k] = a.in[15][i]; }
    f32x4 gv[4], bv[4];
#pragma unroll
    for (int j = 0; j < 4; ++j) { gv[j] = ((const GAS f32x4*)g)[F.lane + 64 * j]; bv[j] = ((const GAS f32x4*)b)[F.lane + 64 * j]; }
    gu32* gcnt = F.ctl + CW_MOE;
    int* tok_e = (int*)(F.ws + WS_TOK + TOK_E); int* tok_slot = (int*)(F.ws + WS_TOK + TOK_SLOT); float* tok_w = (float*)(F.ws + WS_TOK + TOK_W);
    for (int blk = F.vcu; blk < M / 64; blk += F.G) {
        if (F.tid < 16) lcnt[F.tid] = 0;
        __syncthreads();
        int my_e1 = 0, my_e2 = 0, my_l1 = 0, my_l2 = 0; float my_w1 = 0.f;
#pragma unroll 1
        for (int i = 0; i < 8; ++i) {
            const int m = blk * 64 + F.wave * 8 + i;
            const GAS f32x4* xr = (const GAS f32x4*)(src + (size_t)m * D) + F.lane; f32x4 v[4];
#pragma unroll
            for (int j = 0; j < 4; ++j) v[j] = xr[64 * j];
            ln_core(v, gv, bv);
            GAS f32x4* of = (GAS f32x4*)(dstf + (size_t)m * D) + F.lane; GAS v2u* ob = (GAS v2u*)(dstb + (size_t)m * D) + F.lane;
#pragma unroll
            for (int j = 0; j < 4; ++j) { of[64 * j] = v[j]; v2u o; o.x = pk2(v[j][0], v[j][1]); o.y = pk2(v[j][2], v[j][3]); ob[64 * j] = o; }
            float lg[8];
#pragma unroll
            for (int e = 0; e < 8; ++e) { float s = 0.f;
#pragma unroll
                for (int j = 0; j < 4; ++j) { const f32x4 w = ((const LAS f32x4*)(wrT + e * 1024))[F.lane + 64 * j]; s += v[j][0] * w[0] + v[j][1] * w[1] + v[j][2] * w[2] + v[j][3] * w[3]; }
                lg[e] = wave_sum(s); }
            int e1 = 0; float l1 = lg[0];
#pragma unroll
            for (int e = 1; e < 8; ++e) if (lg[e] > l1) { l1 = lg[e]; e1 = e; }
            int e2 = -1; float l2 = -3.0e38f;
#pragma unroll
            for (int e = 0; e < 8; ++e) if (e != e1 && lg[e] > l2) { l2 = lg[e]; e2 = e; }
            const float w1 = 1.f / (1.f + expf(l2 - l1));
            int p1 = 0, p2 = 0;
            if (F.lane == 0) { p1 = __hip_atomic_fetch_add(lcnt + e1, 1, __ATOMIC_RELAXED, __HIP_MEMORY_SCOPE_WORKGROUP); p2 = __hip_atomic_fetch_add(lcnt + e2, 1, __ATOMIC_RELAXED, __HIP_MEMORY_SCOPE_WORKGROUP); }
            p1 = __builtin_amdgcn_readfirstlane(p1); p2 = __builtin_amdgcn_readfirstlane(p2);
            if (F.lane == i) { my_e1 = e1; my_e2 = e2; my_l1 = p1; my_l2 = p2; my_w1 = w1; }
        }
        __syncthreads();
        if (F.tid < 8) lcnt[8 + F.tid] = (int)__hip_atomic_fetch_add(gcnt + 64 * F.tid, (unsigned)lcnt[F.tid], RLX_AGENT);
        __syncthreads();
        if (F.lane < 8) { const int m = blk * 64 + F.wave * 8 + F.lane;
            tok_e[2 * m] = my_e1; tok_e[2 * m + 1] = my_e2; tok_slot[2 * m] = lcnt[8 + my_e1] + my_l1; tok_slot[2 * m + 1] = lcnt[8 + my_e2] + my_l2;
            tok_w[2 * m] = my_w1; tok_w[2 * m + 1] = 1.f - my_w1; }
        __syncthreads();
    }
}
__device__ __forceinline__ void moe_offsets(Frame& F, LAS int* off  , LAS int* tile_e  ) {
    if (F.tid == 0) { int o = 0;
        for (int e = 0; e < 8; ++e) { off[e] = o; const int c = (int)__hip_atomic_load(F.ctl + CW_MOE + 64 * e, RLX_AGENT); o += (c + 255) & ~255; }
        if (o > MOE_MAXT * 256) o = MOE_MAXT * 256;
        off[8] = o; }
    __syncthreads();
    if (F.tid < MOE_MAXT) { int e = 0; const int r = F.tid * 256;
#pragma unroll
        for (int k = 1; k < 8; ++k) if (r >= off[k]) e = k;
        tile_e[F.tid] = e; }
    __syncthreads();
}
__device__ __forceinline__ void gather_phase(Frame& F) {
    LAS int* off = (LAS int*)(F.lds + AUX_OFF); LAS int* tile_e = off + 16;
    moe_offsets(F, off, tile_e);
    const int gw = F.vcu * NWAVES + F.wave, NGW = F.G * NWAVES;
    const int* tok_e = (const int*)(F.ws + WS_TOK + TOK_E); const int* tok_slot = (const int*)(F.ws + WS_TOK + TOK_SLOT); int* tok_row = (int*)(F.ws + WS_TOK + TOK_ROW);
    const bf16* xb = actp<bf16>(F, A_XB); bf16* xg = actp<bf16>(F, A_XG);
    for (int p = gw; p < 2 * M; p += NGW) {
        const int m = p >> 1; const int e = tok_e[p], s = tok_slot[p]; const int row = off[e] + s;
        const GAS v4u* src = (const GAS v4u*)(xb + (size_t)m * D) + F.lane; GAS v4u* dst = (GAS v4u*)(xg + (size_t)row * D) + F.lane;
        const v4u v0 = src[0], v1 = src[64]; dst[0] = v0; dst[64] = v1;
        if (F.lane == 0) tok_row[p] = row;
    }
}
__device__ __forceinline__ void final_phase(Frame& F, const Args& a) {
    const int gw = F.vcu * NWAVES + F.wave, NGW = F.G * NWAVES;
    const float* g = a.in[19] + 3 * D; const float* b = a.in[20] + 3 * D;
    f32x4 gv[4], bv[4];
#pragma unroll
    for (int j = 0; j < 4; ++j) { gv[j] = ((const GAS f32x4*)g)[F.lane + 64 * j]; bv[j] = ((const GAS f32x4*)b)[F.lane + 64 * j]; }
    const int* tok_row = (const int*)(F.ws + WS_TOK + TOK_ROW); const float* tok_w = (const float*)(F.ws + WS_TOK + TOK_W);
    const bf16* y = actp<bf16>(F, A_Y);
    for (int m = gw; m < M; m += NGW) {
        const int r1 = tok_row[2 * m], r2 = tok_row[2 * m + 1]; const float w1 = tok_w[2 * m], w2 = tok_w[2 * m + 1];
        GAS f32x4* xr = (GAS f32x4*)(a.out + (size_t)m * D) + F.lane; const GAS v2u* y1 = (const GAS v2u*)(y + (size_t)r1 * D) + F.lane; const GAS v2u* y2 = (const GAS v2u*)(y + (size_t)r2 * D) + F.lane;
        f32x4 v[4];
#pragma unroll
        for (int j = 0; j < 4; ++j) { const f32x4 x = xr[64 * j]; const v2u p = y1[64 * j], q = y2[64 * j];
            v[j][0] = ALPHA * x[0] + w1 * bflo(p.x) + w2 * bflo(q.x); v[j][1] = ALPHA * x[1] + w1 * bfhi(p.x) + w2 * bfhi(q.x);
            v[j][2] = ALPHA * x[2] + w1 * bflo(p.y) + w2 * bflo(q.y); v[j][3] = ALPHA * x[3] + w1 * bfhi(p.y) + w2 * bfhi(q.y); }
        ln_core(v, gv, bv);
#pragma unroll
        for (int j = 0; j < 4; ++j) xr[64 * j] = v[j];
    }
}
struct MoeOrder {
    int t_lo, nT, nN, nwg, G, c; const LAS int* tile_e;
    __device__ __forceinline__ void init(int t_lo_, int t_hi_, int nN_, int G_, int c_, const LAS int* te) { t_lo = t_lo_; nT = t_hi_ > t_lo_ ? t_hi_ - t_lo_ : 0; nN = nN_; nwg = nT * nN; G = G_; c = c_; tile_e = te; }
    __device__ __forceinline__ bool next(int i, pg8::Unit& u) const {
        const long L = (long)i * G + c; if (L >= nwg) return false;
        int wgid = (int)L; { const int q = nwg / 8, r = nwg % 8, xcd = wgid % 8, o = wgid / 8; wgid = (xcd < r ? xcd * (q + 1) : r * (q + 1) + (xcd - r) * q) + o; }
        const int nig = 8 * nN, gid = wgid / nig, fm = gid * 8, gsz = (nT - fm) < 8 ? (nT - fm) : 8;
        const int pm = t_lo + fm + ((wgid % nig) % gsz), pnl = (wgid % nig) / gsz;
        u.pm = pm; u.pn = tile_e[pm] * nN + pnl; return true;
    }
    __device__ __forceinline__ void a_ready(const pg8::Unit&) const {}
    __device__ __forceinline__ void done(const pg8::Unit&) const {}
};
constexpr int L_QS = 0, L_KS = 17408, L_KG = 34816, L_VB = 52224, L_A = 69632, L_TB = 87040, L_T11T = 96256, L_G = 98816;
__device__ __forceinline__ float fexp(float x) { return __builtin_amdgcn_exp2f(x * LOG2E); }
__device__ __forceinline__ void load_row8(const bf16* base, int t, float (&o)[8]) {
    if (t >= 0) { const v4u v = *(const GAS v4u*)(base + (size_t)t * 1024); unpack8(v, o); }
    else {
#pragma unroll
        for (int e = 0; e < 8; ++e) o[e] = 0.f; }
}
__device__ __forceinline__ bf16x8 gather_col8(const LAS unsigned char* p) {
    unsigned e[8];
#pragma unroll
    for (int j = 0; j < 8; ++j) e[j] = *(const LAS bf16*)(p + j * 272);
    v4u v; v.x = e[0] | (e[1] << 16); v.y = e[2] | (e[3] << 16); v.z = e[4] | (e[5] << 16); v.w = e[6] | (e[7] << 16);
    return __builtin_bit_cast(bf16x8, v);
}
__device__ __forceinline__ void cl_phase(Frame& F, const Args& a) {
    const bf16* QK = actp<bf16>(F, A_QK); const bf16* V = actp<bf16>(F, A_V);
    bf16* U = actp<bf16>(F, A_U); bf16* WP = actp<bf16>(F, A_WP); bf16* QD = actp<bf16>(F, A_QD); bf16* KDT = actp<bf16>(F, A_KDT); bf16* AQK = actp<bf16>(F, A_AQK);
    const float* ablog = (const float*)(F.ws + WS_ABLOG); float* DL = (float*)(F.ws + WS_TOK + TOK_DL);
    const float* conv_w = a.in[2]; const float* a_log = a.in[3]; const float* dt_bias = a.in[4];
    LAS unsigned char* L = F.lds;
    LAS float* gcs = (LAS float*)(L + L_G); LAS float* betas = gcs + 64; LAS float* egs = gcs + 128; LAS float* egls = gcs + 192; LAS float* As = (LAS float*)(L + L_A);
    for (int u = F.vcu; u < BATCH * NCH * GH; u += F.G) {
        int lane_o = F.lane, wave_o = F.wave; asm volatile("" : "+v"(lane_o), "+s"(wave_o));
        const int lane = lane_o, w = wave_o, fr = lane & 15, fq = lane >> 4;
        const int b = u >> 10, n = (u >> 3) & 127, h = u & 7, kh = h >> 1;
        const size_t uidx = (size_t)(b * GH + h) * NCH + n;
        float beta, gc, glast;
        { const int mrow = b * T + n * 64 + lane;
          const float bl = ablog[(size_t)mrow * 16 + h], al = ablog[(size_t)mrow * 16 + 8 + h];
          beta = 1.f / (1.f + expf(-bl));
          const float xx = al + dt_bias[h]; const float sp = fmaxf(xx, 0.f) + log1pf(expf(-fabsf(xx)));
          gc = -expf(a_log[h]) * sp;
#pragma unroll
          for (int d = 1; d < 64; d <<= 1) { const float t = __shfl_up(gc, d); if (lane >= d) gc += t; }
          glast = rdlane(gc, 63);
          if (w == 0) { gcs[lane] = gc; betas[lane] = beta; egs[lane] = fexp(gc); egls[lane] = fexp(glast - gc); if (lane == 0) DL[uidx] = fexp(glast); } }
        if (fq < 3) {
            const int tb = n * 64 + 8 * w;
            const bf16* src; int ch;
            if (fq == 0) { src = QK + (size_t)b * T * 1024 + kh * 128 + 8 * fr; ch = kh * 128 + 8 * fr; }
            else if (fq == 1) { src = QK + (size_t)b * T * 1024 + 512 + kh * 128 + 8 * fr; ch = 512 + kh * 128 + 8 * fr; }
            else { src = V + (size_t)b * T * 1024 + h * 128 + 8 * fr; ch = 1024 + h * 128 + 8 * fr; }
            float cw[4][8];
#pragma unroll
            for (int j = 0; j < 4; ++j) { const f32x4 p = *(const GAS f32x4*)(conv_w + j * 2048 + ch), q = *(const GAS f32x4*)(conv_w + j * 2048 + ch + 4);
                cw[j][0] = p[0]; cw[j][1] = p[1]; cw[j][2] = p[2]; cw[j][3] = p[3]; cw[j][4] = q[0]; cw[j][5] = q[1]; cw[j][6] = q[2]; cw[j][7] = q[3]; }
            float x0[8], x1[8], x2[8], x3[8];
            load_row8(src, tb - 3, x0); load_row8(src, tb - 2, x1); load_row8(src, tb - 1, x2);
#pragma unroll
            for (int i = 0; i < 8; ++i) {
                load_row8(src, tb + i, x3);
                float o[8]; float ss = 0.f;
#pragma unroll
                for (int e = 0; e < 8; ++e) { const float c = cw[0][e] * x0[e] + cw[1][e] * x1[e] + cw[2][e] * x2[e] + cw[3][e] * x3[e]; o[e] = pg8::fast_silu(c); ss += o[e] * o[e]; }
#pragma unroll
                for (int e = 0; e < 8; ++e) { x0[e] = x1[e]; x1[e] = x2[e]; x2[e] = x3[e]; }
                ss += __shfl_xor(ss, 1); ss += __shfl_xor(ss, 2); ss += __shfl_xor(ss, 4); ss += __shfl_xor(ss, 8);
                const int r = 8 * w + i; const float br = rdlane(beta, r), gr = rdlane(gc, r);
                const float rs = 1.f / sqrtf(ss + GDN_EPS);
                if (fq == 0) {
#pragma unroll
                    for (int e = 0; e < 8; ++e) o[e] *= rs * 0.08838834764831845f;
                    *(LAS v4u*)(L + L_QS + r * 272 + fr * 16) = pack8(o);
                } else if (fq == 1) {
#pragma unroll
                    for (int e = 0; e < 8; ++e) o[e] *= rs;
                    *(LAS v4u*)(L + L_KS + r * 272 + fr * 16) = pack8(o);
                    const float sc = br * fexp(gr);
#pragma unroll
                    for (int e = 0; e < 8; ++e) o[e] *= sc;
                    *(LAS v4u*)(L + L_KG + r * 272 + fr * 16) = pack8(o);
                } else {
#pragma unroll
                    for (int e = 0; e < 8; ++e) o[e] *= br;
                    *(LAS v4u*)(L + L_VB + r * 272 + fr * 16) = pack8(o);
                }
            }
        }
        __syncthreads();
        {
            const bool isqk = w >= 4; const int mt = w & 3;
            bf16x8 af[4];
#pragma unroll
            for (int ks = 0; ks < 4; ++ks) af[ks] = *(const LAS bf16x8*)(L + L_KS + (16 * mt + fr) * 272 + (32 * ks + 8 * fq) * 2);
#pragma unroll
            for (int nt = 0; nt < 4; ++nt) {
                f32x4 c = (f32x4){0.f, 0.f, 0.f, 0.f};
                const bool need = isqk ? (mt <= nt) : (nt <= mt);
                if (need) {
#pragma unroll
                    for (int ks = 0; ks < 4; ++ks) { const bf16x8 bfr = *(const LAS bf16x8*)(L + (isqk ? L_QS : L_KS) + (16 * nt + fr) * 272 + (32 * ks + 8 * fq) * 2); c = mfma16(af[ks], bfr, c); }
                }
                const int col = 16 * nt + fr;
                if (!isqk) {
                    const float gj = gcs[col];
#pragma unroll
                    for (int r = 0; r < 4; ++r) { const int i = 16 * mt + 4 * fq + r; const float v = (col < i) ? betas[i] * c[r] * fexp(gcs[i] - gj) : 0.f; As[i * 68 + col] = v; }
                } else {
                    const float gi = gcs[col]; float o4[4];
#pragma unroll
                    for (int r = 0; r < 4; ++r) { const int s = 16 * mt + 4 * fq + r; o4[r] = (s <= col) ? c[r] * fexp(gi - gcs[s]) : 0.f; }
                    v2u o; o.x = pk2(o4[0], o4[1]); o.y = pk2(o4[2], o4[3]);
                    *(GAS v2u*)(AQK + uidx * 4096 + col * 64 + 32 * (mt >> 1) + 8 * fq + 4 * (mt & 1)) = o;
                }
            }
        }
        __syncthreads();
        if (w == 0) {
            const int hl = lane >> 5, cl = lane & 31;
            const LAS float* Ab = As + hl * (32 * 68 + 32);
            float x[32]; float fcl = (float)cl; asm volatile("" : "+v"(fcl));
#pragma unroll
            for (int i = 0; i < 32; ++i) x[i] = 0.f;
#pragma unroll
            for (int i = 0; i < 32; ++i) {
                float s0 = 0.f, s1 = 0.f, s2 = 0.f, s3 = 0.f;
#pragma unroll
                for (int j4 = 0; j4 < i; j4 += 4) { const f32x4 av = *(const LAS f32x4*)(Ab + i * 68 + j4); s0 += av[0] * x[j4]; s1 += av[1] * x[j4 + 1]; s2 += av[2] * x[j4 + 2]; s3 += av[3] * x[j4 + 3]; }
                x[i] = fmaxf(0.f, 1.f - fabsf(fcl - (float)i)) - ((s0 + s1) + (s2 + s3));
                asm volatile("" : "+v"(x[i]) :: "memory");
            }
#pragma unroll
            for (int i = 0; i < 32; ++i) *(LAS bf16*)(L + L_TB + (32 * hl + i) * 144 + (32 * hl + cl) * 2) = (bf16)f2bf(x[i]);
            if (hl == 0) {
#pragma unroll
                for (int q = 0; q < 4; ++q) { v4u o; o.x = pk2(x[8 * q], x[8 * q + 1]); o.y = pk2(x[8 * q + 2], x[8 * q + 3]); o.z = pk2(x[8 * q + 4], x[8 * q + 5]); o.w = pk2(x[8 * q + 6], x[8 * q + 7]);
                    *(LAS v4u*)(L + L_T11T + cl * 80 + q * 16) = o; }
            }
#pragma unroll
            for (int q = 0; q < 2; ++q) { const int p = lane + 64 * q; *(LAS v4u*)(L + L_TB + (p >> 2) * 144 + 64 + (p & 3) * 16) = (v4u){0u, 0u, 0u, 0u}; }
            LDS_WAIT(); asm volatile("" ::: "memory");
            f32x4 Y[2][2];
#pragma unroll
            for (int it = 0; it < 2; ++it) { const LAS f32x4* ar = (const LAS f32x4*)(As + (32 + 16 * it + fr) * 68 + 8 * fq); const bf16x8 afr = frag_from(ar[0], ar[1]);
#pragma unroll
                for (int ct = 0; ct < 2; ++ct) { const bf16x8 bfr = *(const LAS bf16x8*)(L + L_T11T + (16 * ct + fr) * 80 + fq * 16); Y[it][ct] = mfma16(afr, bfr, (f32x4){0.f, 0.f, 0.f, 0.f}); } }
#pragma unroll
            for (int ct = 0; ct < 2; ++ct) { const bf16x8 afr = frag_from(Y[0][ct], Y[1][ct]);
#pragma unroll
                for (int it = 0; it < 2; ++it) { const LAS unsigned char* tp = L + L_TB + (32 + 16 * it + fr) * 144 + (32 + 4 * fq) * 2;
                    const v2u lo = *(const LAS v2u*)tp, hi = *(const LAS v2u*)(tp + 32); v4u bv; bv.x = lo.x; bv.y = lo.y; bv.z = hi.x; bv.w = hi.y;
                    const f32x4 t = mfma16(afr, __builtin_bit_cast(bf16x8, bv), (f32x4){0.f, 0.f, 0.f, 0.f});
                    v2u o; o.x = pk2(-t[0], -t[1]); o.y = pk2(-t[2], -t[3]);
                    *(LAS v2u*)(L + L_TB + (32 + 16 * it + fr) * 144 + (16 * ct + 4 * fq) * 2) = o; } }
        } else {
            const int idx = (w - 1) * 64 + lane;
            for (int p = idx; p < 1024; p += 448) {
                const int i = p >> 4, c16 = p & 15, d0 = 32 * (c16 >> 2) + 4 * (c16 & 3);
                const v2u lo = *(const LAS v2u*)(L + L_QS + i * 272 + d0 * 2), hi = *(const LAS v2u*)(L + L_QS + i * 272 + (d0 + 16) * 2);
                const float eg = egs[i];
                v4u o; o.x = pk2(bflo(lo.x) * eg, bfhi(lo.x) * eg); o.y = pk2(bflo(lo.y) * eg, bfhi(lo.y) * eg); o.z = pk2(bflo(hi.x) * eg, bfhi(hi.x) * eg); o.w = pk2(bflo(hi.y) * eg, bfhi(hi.y) * eg);
                *(GAS v4u*)(QD + uidx * 8192 + i * 128 + c16 * 8) = o;
            }
            for (int p = idx; p < 1024; p += 448) {
                const int dk = p >> 3, c8 = p & 7, t0 = 32 * (c8 >> 2) + 4 * (c8 & 3);
                float o[8];
#pragma unroll
                for (int j = 0; j < 8; ++j) { const int tk = t0 + 16 * (j >> 2) + (j & 3); o[j] = bf2f(*(const LAS bf16*)(L + L_KS + tk * 272 + dk * 2)) * egls[tk]; }
                *(GAS v4u*)(KDT + uidx * 8192 + dk * 64 + c8 * 8) = pack8(o);
            }
        }
        __syncthreads();
        {
            bf16x8 tf[4][2];
#pragma unroll
            for (int t = 0; t < 4; ++t)
#pragma unroll
                for (int ks = 0; ks < 2; ++ks) tf[t][ks] = *(const LAS bf16x8*)(L + L_TB + (16 * t + fr) * 144 + (32 * ks + 8 * fq) * 2);
            bf16x8 vb[2], kg[2];
#pragma unroll
            for (int ks = 0; ks < 2; ++ks) { vb[ks] = gather_col8(L + L_VB + (32 * ks + 8 * fq) * 272 + (16 * w + fr) * 2); kg[ks] = gather_col8(L + L_KG + (32 * ks + 8 * fq) * 272 + (16 * w + fr) * 2); }
#pragma unroll
            for (int t = 0; t < 4; ++t) {
                f32x4 cu = (f32x4){0.f, 0.f, 0.f, 0.f}, cwt = (f32x4){0.f, 0.f, 0.f, 0.f};
#pragma unroll
                for (int ks = 0; ks < 2; ++ks) { cu = mfma16(tf[t][ks], vb[ks], cu); cwt = mfma16(kg[ks], tf[t][ks], cwt); }
                v2u ou; ou.x = pk2(cu[0], cu[1]); ou.y = pk2(cu[2], cu[3]);
                *(GAS v2u*)(U + uidx * 8192 + w * 1024 + t * 256 + lane * 4) = ou;
                v2u ow; ow.x = pk2(cwt[0], cwt[1]); ow.y = pk2(cwt[2], cwt[3]);
                *(GAS v2u*)(WP + uidx * 8192 + (16 * t + fr) * 128 + 32 * (w >> 1) + 8 * fq + 4 * (w & 1)) = ow;
            }
        }
        __syncthreads();
    }
}
constexpr int SC_W = 0, SC_KDT = 17408, SC_BUF = 35840;
__device__ __forceinline__ void scan_phase(Frame& F, int item) {
    const int bh = item >> 1, j2 = item & 1; const int lane = F.lane, w = F.wave, fr = lane & 15, fq = lane >> 4, tid = F.tid;
    bf16* U = actp<bf16>(F, A_U) + (size_t)bh * NCH * 8192; const bf16* WP = actp<bf16>(F, A_WP) + (size_t)bh * NCH * 8192;
    const bf16* KDT = actp<bf16>(F, A_KDT) + (size_t)bh * NCH * 8192; bf16* SST = actp<bf16>(F, A_S) + (size_t)bh * NCH * 16384;
    const float* DL = (const float*)(F.ws + WS_TOK + TOK_DL) + (size_t)bh * NCH;
    LAS unsigned char* L = F.lds;
    const int sl = 4 * j2 + (w & 3);
    const bool comp = w < 4;
    f32x4 S[8];
#pragma unroll
    for (int i = 0; i < 8; ++i) S[i] = (f32x4){0.f, 0.f, 0.f, 0.f};
    v4u pre[4]; v2u upre[4];
#define SC_LOAD(nn) do { const v4u* pw = (const v4u*)(WP + (size_t)(nn) * 8192), *pk = (const v4u*)(KDT + (size_t)(nn) * 8192); \
        pre[0] = pw[tid]; pre[1] = pw[tid + 512]; pre[2] = pk[tid]; pre[3] = pk[tid + 512]; \
        if (comp) { const v2u* pu = (const v2u*)(U + (size_t)(nn) * 8192 + sl * 1024); upre[0] = pu[lane]; upre[1] = pu[64 + lane]; upre[2] = pu[128 + lane]; upre[3] = pu[192 + lane]; } } while (0)
#define SC_STORE(buf) do { LAS unsigned char* B_ = L + (buf) * SC_BUF; \
        *(LAS v4u*)(B_ + SC_W + (tid >> 4) * 272 + (tid & 15) * 16) = pre[0]; *(LAS v4u*)(B_ + SC_W + (32 + (tid >> 4)) * 272 + (tid & 15) * 16) = pre[1]; \
        *(LAS v4u*)(B_ + SC_KDT + (tid >> 3) * 144 + (tid & 7) * 16) = pre[2]; *(LAS v4u*)(B_ + SC_KDT + (64 + (tid >> 3)) * 144 + (tid & 7) * 16) = pre[3]; } while (0)
    SC_LOAD(0); SC_STORE(0);
    v2u ucur[4];
#pragma unroll
    for (int i = 0; i < 4; ++i) ucur[i] = upre[i];
    __syncthreads();
#pragma unroll 1
    for (int n = 0; n < NCH; ++n) {
        const int buf = n & 1; LAS unsigned char* Bp = L + buf * SC_BUF;
        if (n + 1 < NCH) SC_LOAD(n + 1);
        if (comp) {
            const float dl = DL[n];
            bf16x8 Sb[4];
#pragma unroll
            for (int ks = 0; ks < 4; ++ks) { Sb[ks] = frag_from(S[2 * ks], S[2 * ks + 1]); *(GAS bf16x8*)(SST + (size_t)n * 16384 + sl * 2048 + ks * 512 + lane * 8) = Sb[ks]; }
            f32x4 vn[4];
#pragma unroll
            for (int mt = 0; mt < 4; ++mt) {
                f32x4 p = (f32x4){0.f, 0.f, 0.f, 0.f};
#pragma unroll
                for (int ks = 0; ks < 4; ++ks) { const bf16x8 aw = *(const LAS bf16x8*)(Bp + SC_W + (16 * mt + fr) * 272 + (32 * ks + 8 * fq) * 2); p = mfma16(aw, Sb[ks], p); }
                const v2u uu = ucur[mt];
                vn[mt] = (f32x4){bflo(uu.x) - p[0], bfhi(uu.x) - p[1], bflo(uu.y) - p[2], bfhi(uu.y) - p[3]};
            }
            bf16x8 Vb[2];
#pragma unroll
            for (int ks = 0; ks < 2; ++ks) { Vb[ks] = frag_from(vn[2 * ks], vn[2 * ks + 1]); *(GAS bf16x8*)(U + (size_t)n * 8192 + sl * 1024 + ks * 512 + lane * 8) = Vb[ks]; }
#pragma unroll
            for (int mt = 0; mt < 8; ++mt) { f32x4 s = S[mt] * dl;
#pragma unroll
                for (int ks = 0; ks < 2; ++ks) { const bf16x8 ak = *(const LAS bf16x8*)(Bp + SC_KDT + (16 * mt + fr) * 144 + (32 * ks + 8 * fq) * 2); s = mfma16(ak, Vb[ks], s); }
                S[mt] = s; }
        }
        if (n + 1 < NCH) SC_STORE(buf ^ 1);
        __syncthreads();
#pragma unroll
        for (int i = 0; i < 4; ++i) ucur[i] = upre[i];
    }
#undef SC_LOAD
#undef SC_STORE
}
constexpr int GO_QD = 0, GO_AQK = 17408, GO_BUF = 26624;
__device__ __forceinline__ void gdn_out_phase(Frame& F, const Args& a) {
    const int lane = F.lane, w = F.wave, fr = lane & 15, fq = lane >> 4, tid = F.tid;
    LAS unsigned char* L = F.lds; LAS float* part = (LAS float*)(L + AUX_OFF);
    const float nw = a.in[5][16 * w + fr];
    for (int u = F.vcu; u < BATCH * GH * NCH; u += F.G) {
        const int bh = u >> 7, n = u & 127, b = bh >> 3, h = bh & 7;
        const bf16* QD = actp<bf16>(F, A_QD) + (size_t)u * 8192; const bf16* AQK = actp<bf16>(F, A_AQK) + (size_t)u * 4096;
        const bf16* SST = actp<bf16>(F, A_S) + (size_t)u * 16384 + w * 2048; const bf16* VN = actp<bf16>(F, A_U) + (size_t)u * 8192 + w * 1024;
        const bf16* Z = actp<bf16>(F, A_Z) + (size_t)(b * T + n * 64) * 1024 + h * 128 + 16 * w + fr; bf16* OG = actp<bf16>(F, A_OG) + (size_t)(b * T + n * 64) * 1024 + h * 128 + 16 * w + fr;
        { const v4u* pq = (const v4u*)QD; const v4u* pa = (const v4u*)AQK; const v4u q0 = pq[tid], q1 = pq[tid + 512], a0 = pa[tid];
          *(LAS v4u*)(L + GO_QD + (tid >> 4) * 272 + (tid & 15) * 16) = q0; *(LAS v4u*)(L + GO_QD + (32 + (tid >> 4)) * 272 + (tid & 15) * 16) = q1;
          *(LAS v4u*)(L + GO_AQK + (tid >> 3) * 144 + (tid & 7) * 16) = a0; }
        bf16x8 Sb[4], Vb[2];
#pragma unroll
        for (int ks = 0; ks < 4; ++ks) Sb[ks] = *(const GAS bf16x8*)(SST + ks * 512 + lane * 8);
#pragma unroll
        for (int ks = 0; ks < 2; ++ks) Vb[ks] = *(const GAS bf16x8*)(VN + ks * 512 + lane * 8);
        unsigned short zr[16];
#pragma unroll
        for (int mt = 0; mt < 4; ++mt)
#pragma unroll
            for (int r = 0; r < 4; ++r) zr[mt * 4 + r] = Z[(size_t)(16 * mt + 4 * fq + r) * 1024];
        __syncthreads();
        f32x4 O[4];
#pragma unroll
        for (int mt = 0; mt < 4; ++mt) {
            f32x4 o = (f32x4){0.f, 0.f, 0.f, 0.f};
#pragma unroll
            for (int ks = 0; ks < 4; ++ks) { const bf16x8 aq = *(const LAS bf16x8*)(L + GO_QD + (16 * mt + fr) * 272 + (32 * ks + 8 * fq) * 2); o = mfma16(aq, Sb[ks], o); }
#pragma unroll
            for (int ks = 0; ks < 2; ++ks) { const bf16x8 aa = *(const LAS bf16x8*)(L + GO_AQK + (16 * mt + fr) * 144 + (32 * ks + 8 * fq) * 2); o = mfma16(aa, Vb[ks], o); }
            O[mt] = o;
        }
#pragma unroll
        for (int mt = 0; mt < 4; ++mt)
#pragma unroll
            for (int r = 0; r < 4; ++r) { float q = O[mt][r] * O[mt][r]; q += __shfl_xor(q, 1); q += __shfl_xor(q, 2); q += __shfl_xor(q, 4); q += __shfl_xor(q, 8);
                if (fr == 0) part[w * 64 + 16 * mt + 4 * fq + r] = q; }
        __syncthreads();
#pragma unroll
        for (int mt = 0; mt < 4; ++mt)
#pragma unroll
            for (int r = 0; r < 4; ++r) { const int tk = 16 * mt + 4 * fq + r; float q = 0.f;
#pragma unroll
                for (int ww = 0; ww < 8; ++ww) q += part[ww * 64 + tk];
                const float rs = 1.f / sqrtf(q * (1.f / 128.f) + GDN_EPS); const float zz = bf2f(zr[mt * 4 + r]);
                OG[(size_t)tk * 1024] = (bf16)f2bf(O[mt][r] * rs * nw * pg8::fast_silu(zz)); }
        __syncthreads();
    }
}
constexpr int AT_K = 0, AT_VT = 27648, AT_VT_LD = 432, AT_BIAS = AUX_OFF, AT_SINK = AUX_OFF + 8192;
__device__ __forceinline__ void attn_phase(Frame& F, const Args& a) {
    const bf16* Q = actp<bf16>(F, A_Q1); const bf16* K = actp<bf16>(F, A_K1); const bf16* V = actp<bf16>(F, A_V1); bf16* OB = actp<bf16>(F, A_OB);
    LAS unsigned char* L = F.lds; LAS float* bias2 = (LAS float*)(L + AT_BIAS); LAS float* sink2 = (LAS float*)(L + AT_SINK);
    const int lane = F.lane, w = F.wave, fr = lane & 15, fq = lane >> 4, tid = F.tid;
    for (int i = tid; i < 16 * 128; i += 512) { const int hh = i >> 7, dist = i & 127; int bk = dist;
        if (dist >= 16) { bk = 16 + (int)(logf((float)dist / 16.f) / 2.0794415416798357f * 16.f); bk = bk < 31 ? bk : 31; }
        bias2[i] = a.in[11][bk * 16 + hh] * LOG2E; }
    if (tid < 16) sink2[tid] = a.in[9][tid] * LOG2E;
    __syncthreads();
    for (int u = F.vcu; u < BATCH * 2 * (T / 64); u += F.G) {
        const int b = u >> 8, kvh = (u >> 7) & 1, qt = u & 127, t0 = qt * 64, ts = t0 - 128;
        for (int p = tid; p < 1536; p += 512) { const int j = p >> 3, c = p & 7; v4u kv = (v4u){0u, 0u, 0u, 0u}, vv = (v4u){0u, 0u, 0u, 0u};
            if (ts + j >= 0) { const size_t row = (size_t)(b * T + ts + j) * 128 + kvh * 64 + 8 * c; kv = *(const GAS v4u*)(K + row); vv = *(const GAS v4u*)(V + row); }
            *(LAS v4u*)(L + AT_K + j * 144 + c * 16) = kv;
            LAS bf16* vt = (LAS bf16*)(L + AT_VT + (8 * c) * AT_VT_LD + j * 2);
            vt[0 * (AT_VT_LD / 2)] = (bf16)(vv.x & 0xffff); vt[1 * (AT_VT_LD / 2)] = (bf16)(vv.x >> 16); vt[2 * (AT_VT_LD / 2)] = (bf16)(vv.y & 0xffff); vt[3 * (AT_VT_LD / 2)] = (bf16)(vv.y >> 16);
            vt[4 * (AT_VT_LD / 2)] = (bf16)(vv.z & 0xffff); vt[5 * (AT_VT_LD / 2)] = (bf16)(vv.z >> 16); vt[6 * (AT_VT_LD / 2)] = (bf16)(vv.w & 0xffff); vt[7 * (AT_VT_LD / 2)] = (bf16)(vv.w >> 16); }
        for (int p = tid; p < 64 * 16; p += 512) { const int d = p >> 4, j = 192 + (p & 15); *(LAS bf16*)(L + AT_VT + d * AT_VT_LD + j * 2) = 0; }
        __syncthreads();
        const int h = kvh * 8 + w; const float sk = sink2[h];
#pragma unroll 1
        for (int mt = 0; mt < 4; ++mt) {
            bf16x8 qf[2];
#pragma unroll
            for (int ks = 0; ks < 2; ++ks) qf[ks] = *(const GAS bf16x8*)(Q + (size_t)(b * T + t0 + 16 * mt + fr) * 1024 + h * 64 + 32 * ks + 8 * fq);
            f32x4 s[10]; float mx = sk;
#pragma unroll
            for (int nl = 0; nl < 10; ++nl) {
                f32x4 c = (f32x4){0.f, 0.f, 0.f, 0.f}; const int nt = mt + nl;
                if (nt < 12) {
#pragma unroll
                    for (int ks = 0; ks < 2; ++ks) { const bf16x8 kf = *(const LAS bf16x8*)(L + AT_K + (16 * nt + fr) * 144 + (32 * ks + 8 * fq) * 2); c = mfma16(kf, qf[ks], c); }
                }
#pragma unroll
                for (int r = 0; r < 4; ++r) { const int dist = 128 - 16 * nl + fr - 4 * fq - r, j = 16 * nt + 4 * fq + r;
                    const bool ok = (dist >= 0) && (dist < 128) && (ts + j >= 0) && (nt < 12);
                    const float v = ok ? c[r] + bias2[h * 128 + (dist & 127)] : -INFINITY; c[r] = v; mx = fmaxf(mx, v); }
                s[nl] = c;
            }
            mx = fmaxf(mx, __shfl_xor(mx, 16)); mx = fmaxf(mx, __shfl_xor(mx, 32));
            float sum = 0.f;
#pragma unroll
            for (int nl = 0; nl < 10; ++nl)
#pragma unroll
                for (int r = 0; r < 4; ++r) { const float p = __builtin_amdgcn_exp2f(s[nl][r] - mx); s[nl][r] = p; sum += p; }
            sum += __shfl_xor(sum, 16); sum += __shfl_xor(sum, 32);
            sum += __builtin_amdgcn_exp2f(sk - mx);
            const float inv = 1.f / sum;
            bf16x8 pb[5];
#pragma unroll
            for (int kk = 0; kk < 5; ++kk) pb[kk] = frag_from(s[2 * kk], s[2 * kk + 1]);
#pragma unroll
            for (int dt = 0; dt < 4; ++dt) {
                f32x4 o = (f32x4){0.f, 0.f, 0.f, 0.f};
#pragma unroll
                for (int kk = 0; kk < 5; ++kk) { const LAS unsigned char* vp = L + AT_VT + (16 * dt + fr) * AT_VT_LD + (16 * (mt + 2 * kk) + 4 * fq) * 2;
                    const v2u lo = *(const LAS v2u*)vp, hi = *(const LAS v2u*)(vp + 32); v4u av; av.x = lo.x; av.y = lo.y; av.z = hi.x; av.w = hi.y;
                    o = mfma16(__builtin_bit_cast(bf16x8, av), pb[kk], o); }
                v2u ov; ov.x = pk2(o[0] * inv, o[1] * inv); ov.y = pk2(o[2] * inv, o[3] * inv);
                *(GAS v2u*)(OB + (size_t)(b * T + t0 + 16 * mt + fr) * 1024 + h * 64 + 16 * dt + 4 * fq) = ov;
            }
        }
        __syncthreads();
    }
}
constexpr int N_PHASES = 20;
#ifndef MK_CUTS
#define MK_CUTS {0, N_PHASES}
#endif
__global__ void __launch_bounds__(NWAVES * 64, 2) hyb_fwd(Args args) {
    extern __shared__ __attribute__((aligned(16))) unsigned char lds[];
    Frame F;
    F.lds = (LAS unsigned char*)lds; F.MISC = (volatile LAS unsigned*)(F.lds + LDSCTL_OFF);
    F.tid = threadIdx.x; F.lane = F.tid & 63; F.wave = __builtin_amdgcn_readfirstlane(F.tid >> 6);
    F.G = gridDim.x; { const int bx = blockIdx.x; F.vcu = (F.G % 8 == 0) ? (bx % 8) * (F.G / 8) + bx / 8 : bx; }
    F.ws = args.ws; F.ctl = (gu32*)(args.ws + WS_CTL);
    for (int u = F.tid; u < 128; u += NWAVES * 64) ((LAS unsigned*)(F.lds + LDSCTL_OFF))[u] = 0u;
    __syncthreads();
    XcdBarrier bar = xcd_barrier_post((unsigned*)(F.ctl + CW_BAR) + args.li * XCD_BAR_WORDS, F.MISC + 8);
    const int lo = args.ph_lo, hi = args.ph_hi;
#ifndef PHMASK
#define PHMASK 0xfffff
#endif
#define IN(k) ((((PHMASK) >> (k)) & 1) && lo <= (k) && (k) < hi)
#define SEAM(k) do { if (IN(k) && IN((k) + 1)) xcd_barrier(bar); } while (0)
#ifndef DUP_PHASE
#define DUP_PHASE -1
#endif
#define DUP(k) (DUP_PHASE == (k))
    LAS unsigned char* ring = F.lds;
    const int bx = (int)blockIdx.x;

#define RUN(k, ...) do { if (IN(k)) { __VA_ARGS__ } if (DUP(k) && IN(k)) { xcd_barrier(bar); __VA_ARGS__ } SEAM(k); } while (0)
    RUN(0, p0_prologue(F, args); );
    RUN(1,
        pg8::Gemm g{(const bf16*)args.out, (const bf16*)(F.ws + WS_W0T), M, 3072, D}; pg8::StaticOrder S; S.init(M, 3072, F.G, bx);
        pg8::EpiBf16<0> E{actp<bf16>(F, A_QK), D, nullptr, D, (size_t)M * D, 1.f};
        pg8::gemm_phase<pg8::EpiBf16<0>, pg8::StaticOrder, true, true>(ring, g, S, E); );
    RUN(2, cl_phase(F, args); );
    RUN(3, if (bx < 32) scan_phase(F, bx);
           else moe_weight_copies(F, args, (bx - 32) * NWAVES + F.wave, (F.G - 32) * NWAVES); );
    RUN(4, gdn_out_phase(F, args); );
    RUN(5,
        pg8::Gemm g{actp<bf16>(F, A_OG), (const bf16*)(F.ws + WS_WO0T), M, D, D}; pg8::StaticOrder S; S.init(M, D, F.G, bx);
        pg8::EpiResF32 E{actp<float>(F, A_H), args.in[0], D, ALPHA};
        pg8::gemm_phase<pg8::EpiResF32, pg8::StaticOrder, true, true>(ring, g, S, E); );
    RUN(6, ln_phase(F, actp<float>(F, A_H), args.in[19], args.in[20], actp<float>(F, A_X), actp<bf16>(F, A_XB)); );
    RUN(7,
        pg8::Gemm g{actp<bf16>(F, A_XB), (const bf16*)(F.ws + WS_WGU0T), M, 2 * FF, D}; pg8::StaticOrder S; S.init(M, 2 * FF, F.G, bx);
        pg8::EpiSwiglu E{actp<bf16>(F, A_HACT), FF, 1 << 20, 0};
        pg8::gemm_phase<pg8::EpiSwiglu, pg8::StaticOrder, true, true>(ring, g, S, E); );
    RUN(8,
        pg8::Gemm g{actp<bf16>(F, A_HACT), (const bf16*)(F.ws + WS_WD0T), M, D, FF}; pg8::StaticOrder S; S.init(M, D, F.G, bx);
        pg8::EpiResF32 E{actp<float>(F, A_H), actp<float>(F, A_X), D, ALPHA};
        pg8::gemm_phase<pg8::EpiResF32, pg8::StaticOrder, true, true>(ring, g, S, E); );
    RUN(9, ln_phase(F, actp<float>(F, A_H), args.in[19] + D, args.in[20] + D, actp<float>(F, A_X), actp<bf16>(F, A_XB)); );
    RUN(10,
        pg8::Gemm g{actp<bf16>(F, A_XB), (const bf16*)(F.ws + WS_W1T), M, 1280, D}; pg8::StaticOrder S; S.init(M, 1280, F.G, bx);
        pg8::EpiQKV1 E{actp<bf16>(F, A_Q1), actp<bf16>(F, A_K1), actp<bf16>(F, A_V1), args.in[8], 0.125f * LOG2E};
        pg8::gemm_phase<pg8::EpiQKV1, pg8::StaticOrder, true, true>(ring, g, S, E); );
    RUN(11, attn_phase(F, args); );
    RUN(12,
        pg8::Gemm g{actp<bf16>(F, A_OB), (const bf16*)(F.ws + WS_WO1T), M, D, D}; pg8::StaticOrder S; S.init(M, D, F.G, bx);
        pg8::EpiResF32 E{actp<float>(F, A_H), actp<float>(F, A_X), D, ALPHA};
        pg8::gemm_phase<pg8::EpiResF32, pg8::StaticOrder, true, true>(ring, g, S, E); );
    RUN(13, ln3_router_phase(F, args); );
    RUN(14, gather_phase(F); );
#define MOE_UP(pass) { LAS int* off = (LAS int*)(F.lds + AUX_OFF); LAS int* tile_e = off + 16; moe_offsets(F, off, tile_e); \
        const int nT = off[8] >> 8, t_lo = (pass) * MOE_PASS_T < nT ? (pass) * MOE_PASS_T : nT, t_hi = ((pass) + 1) * MOE_PASS_T < nT ? ((pass) + 1) * MOE_PASS_T : nT; \
        pg8::Gemm g{actp<bf16>(F, A_XG), (const bf16*)(F.ws + WS_WGUT), 0, 0, D}; MoeOrder S; S.init(t_lo, t_hi, 28, F.G, bx, tile_e); \
        pg8::EpiSwiglu E{actp<bf16>(F, A_HACT2), ED, 28, t_lo}; \
        pg8::gemm_phase<pg8::EpiSwiglu, MoeOrder, true, true>(ring, g, S, E); }
#define MOE_DOWN(pass) { LAS int* off = (LAS int*)(F.lds + AUX_OFF); LAS int* tile_e = off + 16; moe_offsets(F, off, tile_e); \
        const int nT = off[8] >> 8, t_lo = (pass) * MOE_PASS_T < nT ? (pass) * MOE_PASS_T : nT, t_hi = ((pass) + 1) * MOE_PASS_T < nT ? ((pass) + 1) * MOE_PASS_T : nT; \
        pg8::Gemm g{actp<bf16>(F, A_HACT2) - (size_t)t_lo * 256 * ED, (const bf16*)(F.ws + WS_WDT), 0, 0, ED}; MoeOrder S; S.init(t_lo, t_hi, 4, F.G, bx, tile_e); \
        pg8::EpiMoeOut E{actp<bf16>(F, A_Y), D, 4, 0}; \
        pg8::gemm_phase<pg8::EpiMoeOut, MoeOrder, true, true>(ring, g, S, E); }
    RUN(15, MOE_UP(0) );
    RUN(16, MOE_DOWN(0) );
    RUN(17, MOE_UP(1) );
    RUN(18, MOE_DOWN(1) );
    RUN(19, final_phase(F, args); );
#undef IN
#undef SEAM
}

extern "C" void kernel_launch(void* const* d_in, const int* in_sizes, int n_in, void* d_out, int out_size, void* d_ws, size_t ws_size, hipStream_t stream) {
    static int grid = 0;
    if (grid == 0) {
        if (n_in != 21 || out_size != M * D || ws_size < WS_END) { fprintf(stderr, "kernel_launch: unexpected shapes (n_in %d, out %d, ws %zu)\n", n_in, out_size, ws_size); grid = -1; return; }
        int dev = 0, cus = 0, per_cu = 0;
        if (hipGetDevice(&dev) != hipSuccess || hipDeviceGetAttribute(&cus, hipDeviceAttributeMultiprocessorCount, dev) != hipSuccess) { grid = -1; return; }
        if (hipFuncSetAttribute((const void*)hyb_fwd, hipFuncAttributeMaxDynamicSharedMemorySize, LDS_BYTES) != hipSuccess) { fprintf(stderr, "kernel_launch: hipFuncSetAttribute failed\n"); grid = -1; return; }
        if (hipOccupancyMaxActiveBlocksPerMultiprocessor(&per_cu, (const void*)hyb_fwd, NWAVES * 64, LDS_BYTES) != hipSuccess || per_cu < 1) fprintf(stderr, "kernel_launch: occupancy query reports %d\n", per_cu);
        (void)hipGetLastError();
        grid = cus;
    }
    if (grid < 0) return;
    (void)hipMemsetAsync((char*)d_ws + WS_CTL, 0, CTL_ZERO_BYTES, stream);
    Args a{};
    for (int i = 0; i < 21; ++i) a.in[i] = (const float*)d_in[i];
    a.out = (float*)d_out; a.ws = (unsigned char*)d_ws; a.dbg = 0;
    const int cuts[] = MK_CUTS; const int ncut = (int)(sizeof(cuts) / sizeof(cuts[0]));
    for (int li = 0; li + 1 < ncut; ++li) {
        a.ph_lo = cuts[li]; a.ph_hi = cuts[li + 1]; a.li = li;
        hipLaunchKernelGGL(hyb_fwd, dim3(grid), dim3(NWAVES * 64), LDS_BYTES, stream, a);
    }
}
```

```cpp
#include <hip/hip_runtime.h>
#include <cstdio>
#include <cstdint>
namespace pg8 {
#define PG8_LAS __attribute__((address_space(3)))
typedef unsigned short bf16_t;
typedef short bf16x8 __attribute__((ext_vector_type(8)));
typedef float f32x4 __attribute__((ext_vector_type(4)));
typedef unsigned u32x4 __attribute__((ext_vector_type(4)));
constexpr int BM = 256, BK = 64, HALF = 128, HTB = HALF * BK * 2  , STAGE_BYTES = 8 * HTB, NXCD = 8, WGM = 8;

__host__ __device__ __forceinline__ int lds_byte(int r, int c) { const int st = (r >> 4) * 2 + (c >> 5), rr = r & 15, cc = c & 31, ob = rr * 64 + cc * 2; return st * 1024 + (ob ^ (((ob >> 9) & 1) << 5)); }
__host__ __device__ __forceinline__ void stage_rc(int b, int& R, int& C) { const int st = b / 1024, sb = b % 1024, swz = sb ^ (((sb >> 9) & 1) << 5); R = (st >> 1) * 16 + swz / 64; C = (st & 1) * 32 + (swz % 64) / 2; }
__host__ __device__ __forceinline__ int perm32(int rho) { const int n = rho >> 4, i = rho & 15; return 8 * (i >> 2) + 4 * n + (i & 3); }

struct Unit { int pm, pn; };
struct Gemm { const bf16_t* A; const bf16_t* Bt; int M, N, K; };

struct StaticOrder {
    int nM, nN, nwg, G, c;
    __host__ __device__ void init(int M, int N, int G_, int c_) { nM = M / BM; nN = N / BM; nwg = nM * nN; G = G_; c = c_; }
    __host__ __device__ bool next(int i, Unit& u) const {
        const long L = (long)i * G + c; if (L >= nwg) return false;
        int wgid = (int)L; { const int q = nwg / NXCD, r = nwg % NXCD, xcd = wgid % NXCD, off = wgid / NXCD; wgid = (xcd < r ? xcd * (q + 1) : r * (q + 1) + (xcd - r) * q) + off; }
        const int nig = WGM * nN, gid = wgid / nig, fm = gid * WGM, gsz = (nM - fm) < WGM ? (nM - fm) : WGM;
        u.pm = fm + ((wgid % nig) % gsz); u.pn = (wgid % nig) / gsz; return true;
    }
    __device__ __forceinline__ void a_ready(const Unit&) const {}
    __device__ __forceinline__ void done(const Unit&) const {}
    __device__ __forceinline__ const char* a_tile(const Gemm& g, const Unit& u, size_t tstep) const { return (const char*)g.A + (size_t)u.pm * tstep; }
};

__device__ __forceinline__ unsigned cvt_pk_bf16(float lo, float hi) { unsigned r; asm volatile("v_cvt_pk_bf16_f32 %0, %1, %2" : "=v"(r) : "v"(lo), "v"(hi)); return r; }
typedef float f32x2 __attribute__((ext_vector_type(2)));
template <int ACT  > struct EpiBf16 {
    static constexpr bool PERM = true, AFTER_DRAIN = false; static_assert(ACT == 0, "EpiBf16: ACT is 0");
    bf16_t* O; int ldc; const float* bias; int split_cols; size_t split_stride; float scale0;
    __device__ __forceinline__ void operator()(const f32x4 (&acc)[2][2][4][2], const Unit& u, int wr, int wc, int fr, int fq) const {
        const int row0 = u.pm * BM + wr * 64 + fr; int colt = u.pn * BM; bf16_t* base = O;
        float sc = 1.f; if (split_cols) { const int t = colt / split_cols; base += (size_t)t * split_stride; colt -= t * split_cols; if (t == 0) sc = scale0; }
        const int col0 = colt + wc * 32 + 8 * fq, bcol0 = u.pn * BM + wc * 32 + 8 * fq;
        f32x4 bv[2][2];
#pragma unroll
        for (int bj = 0; bj < 2; ++bj)
#pragma unroll
            for (int n = 0; n < 2; ++n) bv[bj][n] = bias ? *(const f32x4*)(bias + bcol0 + bj * HALF + 4 * n) : (f32x4){0.f, 0.f, 0.f, 0.f};
#pragma unroll
        for (int ai = 0; ai < 2; ++ai)
#pragma unroll
            for (int m = 0; m < 4; ++m) { bf16_t* rowp = base + (size_t)(row0 + ai * HALF + m * 16) * ldc + col0;
#pragma unroll
                for (int bj = 0; bj < 2; ++bj) { f32x4 v0 = acc[ai][bj][m][0] + bv[bj][0], v1 = acc[ai][bj][m][1] + bv[bj][1];
                    v0 = v0 * sc; v1 = v1 * sc; u32x4 w; w.x = cvt_pk_bf16(v0[0], v0[1]); w.y = cvt_pk_bf16(v0[2], v0[3]); w.z = cvt_pk_bf16(v1[0], v1[1]); w.w = cvt_pk_bf16(v1[2], v1[3]);
                    *(u32x4*)(rowp + bj * HALF) = w; } }
    }
};
__device__ __forceinline__ float fast_silu(float x) { return x * __builtin_amdgcn_rcpf(1.0f + __builtin_amdgcn_exp2f(-1.4426950408889634f * x)); }
struct EpiResF32 {
    static constexpr bool PERM = false, AFTER_DRAIN = false;
    float* C; const float* res; int ldc; float alpha;
    __device__ __forceinline__ void operator()(const f32x4 (&acc)[2][2][4][2], const Unit& u, int wr, int wc, int fr, int fq) const {
        const int row0 = u.pm * BM + wr * 64 + fr, col0 = u.pn * BM + wc * 32 + 4 * fq;
#pragma unroll
        for (int ai = 0; ai < 2; ++ai)
#pragma unroll
            for (int m = 0; m < 4; ++m) { const size_t off = (size_t)(row0 + ai * HALF + m * 16) * ldc + col0;
#pragma unroll
                for (int bj = 0; bj < 2; ++bj)
#pragma unroll
                    for (int n = 0; n < 2; ++n) { const f32x4 r = *(const f32x4*)(res + off + bj * HALF + n * 16); *(f32x4*)(C + off + bj * HALF + n * 16) = r * alpha + acc[ai][bj][m][n]; } }
    }
};
struct EpiSwiglu {
    static constexpr bool PERM = true, AFTER_DRAIN = false;
    bf16_t* O; int ldc; int nN; int pm_off;
    __device__ __forceinline__ void operator()(const f32x4 (&acc)[2][2][4][2], const Unit& u, int wr, int wc, int fr, int fq) const {
        const int row0 = (u.pm - pm_off) * BM + wr * 64 + fr, col0 = (u.pn % nN) * HALF + wc * 32 + 8 * fq;
#pragma unroll
        for (int ai = 0; ai < 2; ++ai)
#pragma unroll
            for (int m = 0; m < 4; ++m) { bf16_t* rowp = O + (size_t)(row0 + ai * HALF + m * 16) * ldc + col0;
                const f32x4 g0 = acc[ai][0][m][0], g1 = acc[ai][0][m][1], u0 = acc[ai][1][m][0], u1 = acc[ai][1][m][1];
                u32x4 w;
                w.x = cvt_pk_bf16(fast_silu(g0[0]) * u0[0], fast_silu(g0[1]) * u0[1]); w.y = cvt_pk_bf16(fast_silu(g0[2]) * u0[2], fast_silu(g0[3]) * u0[3]);
                w.z = cvt_pk_bf16(fast_silu(g1[0]) * u1[0], fast_silu(g1[1]) * u1[1]); w.w = cvt_pk_bf16(fast_silu(g1[2]) * u1[2], fast_silu(g1[3]) * u1[3]);
                *(u32x4*)rowp = w; }
    }
};
struct HSeg { unsigned char* a; unsigned char* b; unsigned char* c; int ta, tb; size_t tile_bytes;
    __device__ __forceinline__ unsigned char* tile(int pm) const { return pm < ta ? a + (size_t)pm * tile_bytes : (pm < ta + tb ? b + (size_t)(pm - ta) * tile_bytes : c + (size_t)(pm - ta - tb) * tile_bytes); } };
struct EpiSwigluSeg {
    static constexpr bool PERM = true, AFTER_DRAIN = false;
    HSeg seg; int ldc; int nN;
    __device__ __forceinline__ void operator()(const f32x4 (&acc)[2][2][4][2], const Unit& u, int wr, int wc, int fr, int fq) const {
        bf16_t* O = (bf16_t*)seg.tile(u.pm);
        const int row0 = wr * 64 + fr, col0 = (u.pn % nN) * HALF + wc * 32 + 8 * fq;
#pragma unroll
        for (int ai = 0; ai < 2; ++ai)
#pragma unroll
            for (int m = 0; m < 4; ++m) { bf16_t* rowp = O + (size_t)(row0 + ai * HALF + m * 16) * ldc + col0;
                const f32x4 g0 = acc[ai][0][m][0], g1 = acc[ai][0][m][1], u0 = acc[ai][1][m][0], u1 = acc[ai][1][m][1];
                u32x4 w;
                w.x = cvt_pk_bf16(fast_silu(g0[0]) * u0[0], fast_silu(g0[1]) * u0[1]); w.y = cvt_pk_bf16(fast_silu(g0[2]) * u0[2], fast_silu(g0[3]) * u0[3]);
                w.z = cvt_pk_bf16(fast_silu(g1[0]) * u1[0], fast_silu(g1[1]) * u1[1]); w.w = cvt_pk_bf16(fast_silu(g1[2]) * u1[2], fast_silu(g1[3]) * u1[3]);
                *(u32x4*)rowp = w; }
    }
};
struct EpiMoeOut {
    static constexpr bool PERM = true, AFTER_DRAIN = false;
    bf16_t* O; int ldc; int nN; int pm_off;
    __device__ __forceinline__ void operator()(const f32x4 (&acc)[2][2][4][2], const Unit& u, int wr, int wc, int fr, int fq) const {
        const int row0 = (u.pm - pm_off) * BM + wr * 64 + fr, col0 = (u.pn % nN) * BM + wc * 32 + 8 * fq;
#pragma unroll
        for (int ai = 0; ai < 2; ++ai)
#pragma unroll
            for (int m = 0; m < 4; ++m) { bf16_t* rowp = O + (size_t)(row0 + ai * HALF + m * 16) * ldc + col0;
#pragma unroll
                for (int bj = 0; bj < 2; ++bj) { const f32x4 v0 = acc[ai][bj][m][0], v1 = acc[ai][bj][m][1];
                    u32x4 w; w.x = cvt_pk_bf16(v0[0], v0[1]); w.y = cvt_pk_bf16(v0[2], v0[3]); w.z = cvt_pk_bf16(v1[0], v1[1]); w.w = cvt_pk_bf16(v1[2], v1[3]);
                    *(u32x4*)(rowp + bj * HALF) = w; } }
    }
};
struct EpiQKV1 {
    static constexpr bool PERM = true, AFTER_DRAIN = false;
    bf16_t* Q; bf16_t* Kb; bf16_t* Vb; const float* bias; float qscale;
    __device__ __forceinline__ void operator()(const f32x4 (&acc)[2][2][4][2], const Unit& u, int wr, int wc, int fr, int fq) const {
        const int row0 = u.pm * BM + wr * 64 + fr, cw = wc * 32 + 8 * fq, bcol0 = u.pn * BM + cw;
        const bool isq = u.pn < 4; const float sc = isq ? qscale : 1.f;
        f32x4 bv[2][2];
#pragma unroll
        for (int bj = 0; bj < 2; ++bj)
#pragma unroll
            for (int n = 0; n < 2; ++n) bv[bj][n] = *(const f32x4*)(bias + bcol0 + bj * HALF + 4 * n);
#pragma unroll
        for (int ai = 0; ai < 2; ++ai)
#pragma unroll
            for (int m = 0; m < 4; ++m) { const size_t row = (size_t)(row0 + ai * HALF + m * 16);
#pragma unroll
                for (int bj = 0; bj < 2; ++bj) { const f32x4 v0 = (acc[ai][bj][m][0] + bv[bj][0]) * sc, v1 = (acc[ai][bj][m][1] + bv[bj][1]) * sc;
                    u32x4 w; w.x = cvt_pk_bf16(v0[0], v0[1]); w.y = cvt_pk_bf16(v0[2], v0[3]); w.z = cvt_pk_bf16(v1[0], v1[1]); w.w = cvt_pk_bf16(v1[2], v1[3]);
                    bf16_t* dst = isq ? (Q + row * 1024 + u.pn * BM + bj * HALF + cw) : ((bj == 0 ? Kb : Vb) + row * 128 + cw);
                    *(u32x4*)dst = w; } }
    }
};
template <class Epi, class Sched, bool ALIGN_EPI = false, bool SP2 = false>
__device__ __forceinline__ void gemm_phase(PG8_LAS unsigned char* lds, const Gemm g, const Sched& S, const Epi& E) {
    const int tid = threadIdx.x, wid = __builtin_amdgcn_readfirstlane(tid >> 6), lane = tid & 63, wr = wid >> 2, wc = wid & 3, fr = lane & 15, fq = lane >> 4;
    const int K = g.K, nt = K / BK;
    unsigned voffA[2], voffB[2];
#pragma unroll
    for (int i = 0; i < 2; ++i) { int R, C; stage_rc(tid * 16 + i * 8192, R, C); const int Rb = Epi::PERM ? ((R & ~31) + perm32(R & 31)) : R;
        voffA[i] = (unsigned)(R * K + C) * 2u; voffB[i] = (unsigned)(Rb * K + C) * 2u; }
    const size_t kstep = (size_t)(BK * 2);
    const size_t hstep = (size_t)HALF * K * 2;
    const size_t tstep = 2 * hstep;
    const unsigned ldsw = (unsigned)wid * 1024u;
    const int aoff = lds_byte(wr * 64 + fr, fq * 8), boff = lds_byte(wc * 32 + fr, fq * 8);
#define PG8_SA(b, h) (((b) * 2 + (h)) * HTB)
#define PG8_SB(b, h) ((4 + (b) * 2 + (h)) * HTB)
#define PG8_STAGE(bufoff, gbase, voff) do { _Pragma("unroll") for (int _i = 0; _i < 2; ++_i) \
        __builtin_amdgcn_global_load_lds((const unsigned*)((const char*)(gbase) + (voff)[_i]), (PG8_LAS unsigned*)(lds + (bufoff) + ldsw + _i * 8192), 16, 0, 0); } while (0)
#define PG8_LDA(dst, b, h) do { _Pragma("unroll") for (int m = 0; m < 4; ++m) _Pragma("unroll") for (int k = 0; k < 2; ++k) dst[m][k] = *(const PG8_LAS bf16x8*)(lds + PG8_SA(b, h) + aoff + m * 2048 + k * 1024); } while (0)
#define PG8_LDB(dst, b, h) do { _Pragma("unroll") for (int n = 0; n < 2; ++n) _Pragma("unroll") for (int k = 0; k < 2; ++k) dst[n][k] = *(const PG8_LAS bf16x8*)(lds + PG8_SB(b, h) + boff + n * 2048 + k * 1024); } while (0)
#define PG8_MMA(ai, bj, At, Bt) do { __builtin_amdgcn_s_setprio(1); _Pragma("unroll") for (int m = 0; m < 4; ++m) _Pragma("unroll") for (int n = 0; n < 2; ++n) _Pragma("unroll") for (int k = 0; k < 2; ++k) \
        acc[ai][bj][m][n] = __builtin_amdgcn_mfma_f32_16x16x32_bf16(Bt[n][k], At[m][k], acc[ai][bj][m][n], 0, 0, 0); __builtin_amdgcn_s_setprio(0); } while (0)
#define PG8_WAIT_V(n) asm volatile("s_waitcnt vmcnt(" #n ")" ::: "memory")
#define PG8_WAIT_L(n) asm volatile("s_waitcnt lgkmcnt(" #n ")" ::: "memory")
#define PG8_BAR __builtin_amdgcn_s_barrier()
#define PG8_SCHED __builtin_amdgcn_sched_barrier(0)
    Unit cur, nxt; int ui = 0;
    if (!S.next(0, cur)) return;
    f32x4 acc[2][2][4][2];
#pragma unroll
    for (int a = 0; a < 2; ++a)
#pragma unroll
        for (int b = 0; b < 2; ++b)
#pragma unroll
            for (int m = 0; m < 4; ++m)
#pragma unroll
                for (int n = 0; n < 2; ++n) acc[a][b][m][n] = (f32x4){0.f, 0.f, 0.f, 0.f};
    bf16x8 At[4][2], B0[2][2], B1[2][2];
    const char* cA = S.a_tile(g, cur, tstep); const char* cB = (const char*)g.Bt + (size_t)cur.pn * tstep;
    S.a_ready(cur);
    if constexpr (SP2) {
        PG8_STAGE(PG8_SB(0, 0), cB, voffB); PG8_STAGE(PG8_SB(0, 1), cB + hstep, voffB); PG8_STAGE(PG8_SA(0, 0), cA, voffA); PG8_STAGE(PG8_SA(0, 1), cA + hstep, voffA);
        if (wr == 1) PG8_BAR;
        PG8_WAIT_V(2); PG8_BAR;
        PG8_STAGE(PG8_SB(1, 0), cB + kstep, voffB); PG8_STAGE(PG8_SA(1, 0), cA + kstep, voffA); PG8_STAGE(PG8_SB(1, 1), cB + hstep + kstep, voffB);
        PG8_WAIT_V(6); PG8_BAR;
    } else {
        PG8_STAGE(PG8_SB(0, 0), cB, voffB); PG8_STAGE(PG8_SA(0, 0), cA, voffA); PG8_STAGE(PG8_SB(0, 1), cB + hstep, voffB); PG8_STAGE(PG8_SA(0, 1), cA + hstep, voffA);
        if (wr == 1) PG8_BAR;
        PG8_WAIT_V(4); PG8_BAR;
        PG8_STAGE(PG8_SB(1, 0), cB + kstep, voffB); PG8_STAGE(PG8_SA(1, 0), cA + kstep, voffA); PG8_STAGE(PG8_SB(1, 1), cB + hstep + kstep, voffB);
        PG8_WAIT_V(6); PG8_BAR;
    }
    for (;;) {
        const bool has_next = S.next(ui + 1, nxt);
        const char* nA = has_next ? S.a_tile(g, nxt, tstep) : cA; const char* nB = has_next ? (const char*)g.Bt + (size_t)nxt.pn * tstep : cB;
        for (int t = 0; t < nt; t += 2) {
            const bool last = (t == nt - 2);
            const char* a1 = cA + (size_t)(t + 1) * kstep;
            const char* a2 = last ? nA : cA + (size_t)(t + 2) * kstep; const char* b2 = last ? nB : cB + (size_t)(t + 2) * kstep;
            const char* a3 = a2 + kstep; const char* b3 = b2 + kstep;
            if (last && has_next) S.a_ready(nxt);
            if constexpr (SP2) {
            PG8_LDB(B0, 0, 0); PG8_LDB(B1, 0, 1); PG8_SCHED; PG8_LDA(At, 0, 0); PG8_STAGE(PG8_SA(1, 1), a1 + hstep, voffA);
            PG8_WAIT_V(8); PG8_WAIT_L(0); PG8_BAR; PG8_MMA(0, 0, At, B0); PG8_MMA(0, 1, At, B1); PG8_BAR; PG8_SCHED;
            PG8_LDA(At, 0, 1); PG8_STAGE(PG8_SB(0, 0), b2, voffB); PG8_STAGE(PG8_SB(0, 1), b2 + hstep, voffB); PG8_STAGE(PG8_SA(0, 0), a2, voffA);
            PG8_WAIT_V(8); PG8_WAIT_L(0); PG8_BAR; PG8_MMA(1, 0, At, B0); PG8_MMA(1, 1, At, B1); PG8_BAR; PG8_SCHED;
            PG8_LDB(B0, 1, 0); PG8_LDB(B1, 1, 1); PG8_SCHED; PG8_LDA(At, 1, 0); PG8_STAGE(PG8_SA(0, 1), a2 + hstep, voffA);
            PG8_WAIT_V(8); PG8_WAIT_L(0); PG8_BAR; PG8_MMA(0, 0, At, B0); PG8_MMA(0, 1, At, B1); PG8_BAR; PG8_SCHED;
            PG8_LDA(At, 1, 1); PG8_STAGE(PG8_SB(1, 0), b3, voffB); PG8_STAGE(PG8_SB(1, 1), b3 + hstep, voffB); PG8_STAGE(PG8_SA(1, 0), a3, voffA);
            PG8_WAIT_V(8); PG8_WAIT_L(0); PG8_BAR; PG8_MMA(1, 0, At, B0); PG8_MMA(1, 1, At, B1); PG8_BAR; PG8_SCHED;
            } else {
            PG8_LDB(B0, 0, 0); PG8_SCHED; PG8_LDA(At, 0, 0); PG8_STAGE(PG8_SA(1, 1), a1 + hstep, voffA);
            PG8_WAIT_L(8); PG8_BAR; PG8_WAIT_L(0); PG8_MMA(0, 0, At, B0); PG8_BAR; PG8_SCHED;
            PG8_LDB(B1, 0, 1); PG8_STAGE(PG8_SB(0, 0), b2, voffB);
            PG8_BAR; PG8_WAIT_L(0); PG8_MMA(0, 1, At, B1); PG8_BAR;
            PG8_LDA(At, 0, 1); PG8_STAGE(PG8_SA(0, 0), a2, voffA);
            PG8_BAR; PG8_WAIT_L(0); PG8_MMA(1, 0, At, B0); PG8_BAR; PG8_SCHED;
            PG8_STAGE(PG8_SB(0, 1), b2 + hstep, voffB);
            PG8_WAIT_V(6); PG8_BAR; PG8_MMA(1, 1, At, B1); PG8_BAR;
            PG8_LDB(B0, 1, 0); PG8_SCHED; PG8_LDA(At, 1, 0); PG8_STAGE(PG8_SA(0, 1), a2 + hstep, voffA);
            PG8_WAIT_L(8); PG8_BAR; PG8_WAIT_L(0); PG8_MMA(0, 0, At, B0); PG8_BAR; PG8_SCHED;
            PG8_LDB(B1, 1, 1); PG8_STAGE(PG8_SB(1, 0), b3, voffB);
            PG8_BAR; PG8_WAIT_L(0); PG8_MMA(0, 1, At, B1); PG8_BAR;
            PG8_LDA(At, 1, 1); PG8_STAGE(PG8_SA(1, 0), a3, voffA);
            PG8_BAR; PG8_WAIT_L(0); PG8_MMA(1, 0, At, B0); PG8_BAR; PG8_SCHED;
            PG8_STAGE(PG8_SB(1, 1), b3 + hstep, voffB);
            PG8_WAIT_V(6); PG8_BAR; PG8_MMA(1, 1, At, B1); PG8_BAR;
            }
        }
        if constexpr (ALIGN_EPI) { if (wr == 0) PG8_BAR; }
        if constexpr (!Epi::AFTER_DRAIN) { E(acc, cur, wr, wc, fr, fq); S.done(cur); }
        if (!has_next) break;
#pragma unroll
        for (int a = 0; a < 2; ++a)
#pragma unroll
            for (int b = 0; b < 2; ++b)
#pragma unroll
                for (int m = 0; m < 4; ++m)
#pragma unroll
                    for (int n = 0; n < 2; ++n) acc[a][b][m][n] = (f32x4){0.f, 0.f, 0.f, 0.f};
        cur = nxt; cA = nA; cB = nB; ++ui;
        if constexpr (ALIGN_EPI) { if (wr == 1) PG8_BAR; }
    }
    PG8_WAIT_V(0);
    if constexpr (!ALIGN_EPI) { if (wr == 0) PG8_BAR; }
    PG8_BAR;
    if constexpr (Epi::AFTER_DRAIN) { E.fused(acc, cur, wr, wc, fr, fq, lds, wid, lane); S.done(cur); }
#undef PG8_SA
#undef PG8_SB
#undef PG8_STAGE
#undef PG8_LDA
#undef PG8_LDB
#undef PG8_MMA
#undef PG8_WAIT_V
#undef PG8_WAIT_L
#undef PG8_BAR
#undef PG8_SCHED
}
}
constexpr int BATCH = 2, T = 8192, D = 1024, M = BATCH * T;
constexpr int GH = 8, CH = 64, NCH = T / CH;
constexpr int GIN = 3088, FF = 2816, NE = 8, ED = 3584;
constexpr float ALPHA = 1.4142135623730951f, LN_EPS = 1e-5f, GDN_EPS = 1e-6f, LOG2E = 1.4426950408889634f;
constexpr int NWAVES = 8;
constexpr size_t MiB = (size_t)1 << 20;
constexpr size_t WS_CTL = 0, CTL_ZERO_BYTES = 1 * MiB;
constexpr size_t WS_W0T = 1 * MiB, WS_WO0T = 7 * MiB, WS_WGU0T = 9 * MiB, WS_WD0T = 20 * MiB, WS_W1T = 26 * MiB, WS_WO1T = 29 * MiB;
constexpr size_t WS_ABLOG = 31 * MiB, WS_TOK = 32 * MiB;
constexpr size_t TOK_DL = 0, TOK_E = 64 * 1024, TOK_SLOT = 192 * 1024, TOK_W = 320 * 1024, TOK_ROW = 448 * 1024;
constexpr size_t WS_WGUT = 34 * MiB, WS_WDT = 146 * MiB, WS_ACT = 202 * MiB, WS_END = 458 * MiB;
constexpr size_t A_QK = 0, A_V = 32 * MiB, A_S = 0, A_Z = 64 * MiB, A_U = 96 * MiB, A_WP = 128 * MiB, A_QD = 160 * MiB, A_KDT = 192 * MiB, A_AQK = 224 * MiB, A_OG = 192 * MiB;
constexpr size_t A_H = 0, A_X = 64 * MiB, A_XB = 128 * MiB, A_HACT = 160 * MiB;
constexpr size_t A_Q1 = 160 * MiB, A_K1 = 192 * MiB, A_V1 = 196 * MiB, A_OB = 200 * MiB;
constexpr size_t A_X3B = 0, A_XG = 32 * MiB, A_Y = 32 * MiB;
constexpr int MOE_MAXT = 136;
constexpr size_t HTILE = (size_t)256 * ED * 2, A_HSEG_A = 100 * MiB; constexpr int HSEG_A_T = 89, HSEG_B_T = 36, HSEG_C_T = 17;
static_assert(A_HSEG_A + HSEG_A_T * HTILE <= 256 * MiB && HSEG_B_T * HTILE <= 64 * MiB && HSEG_C_T * HTILE <= 30 * MiB && HSEG_A_T + HSEG_B_T + HSEG_C_T >= MOE_MAXT && A_XG + (size_t)MOE_MAXT * 256 * D * 2 <= A_HSEG_A, "MoE map");
constexpr int CW_TMO = 0, CW_CODE = 1, CW_BAR = 4096, CW_MOE = 131072, CW_DBG = 196608;
constexpr int RING_BYTES = 131072, AUX_OFF = 131072, AUX_BYTES = 24576, LDSCTL_OFF = AUX_OFF + AUX_BYTES, LDS_BYTES = LDSCTL_OFF + 512;

#define GAS __attribute__((address_space(1)))
#define LAS __attribute__((address_space(3)))
typedef unsigned short bf16;
typedef unsigned v4u __attribute__((ext_vector_type(4)));
typedef unsigned v2u __attribute__((ext_vector_type(2)));
typedef float f32x4 __attribute__((ext_vector_type(4)));
typedef short bf16x8 __attribute__((ext_vector_type(8)));
typedef GAS unsigned gu32;
#define RLX_AGENT __ATOMIC_RELAXED, __HIP_MEMORY_SCOPE_AGENT
#define LDS_WAIT() asm volatile("s_waitcnt lgkmcnt(0)" ::: "memory")
#define VM_WAIT() asm volatile("s_waitcnt vmcnt(0)" ::: "memory")
#define WG_BAR_LDS() do { asm volatile("s_waitcnt lgkmcnt(0)" ::: "memory"); __builtin_amdgcn_s_barrier(); asm volatile("" ::: "memory"); } while (0)
__device__ __forceinline__ unsigned f2bf(float f) { unsigned u = __builtin_bit_cast(unsigned, f); return (u + 0x7fffu + ((u >> 16) & 1u)) >> 16; }
typedef float f32x2_t __attribute__((ext_vector_type(2))); typedef __bf16 bf16x2_t __attribute__((ext_vector_type(2)));
__device__ __forceinline__ unsigned pk2(float lo, float hi) { const f32x2_t v = {lo, hi}; const bf16x2_t b = __builtin_convertvector(v, bf16x2_t); return __builtin_bit_cast(unsigned, b); }
__device__ __forceinline__ float bf2f(unsigned b) { return __builtin_bit_cast(float, b << 16); }
__device__ __forceinline__ float bflo(unsigned w) { return __builtin_bit_cast(float, w << 16); }
__device__ __forceinline__ float bfhi(unsigned w) { return __builtin_bit_cast(float, w & 0xffff0000u); }
__device__ __forceinline__ void unpack8(const v4u v, float (&o)[8]) { o[0] = bflo(v.x); o[1] = bfhi(v.x); o[2] = bflo(v.y); o[3] = bfhi(v.y); o[4] = bflo(v.z); o[5] = bfhi(v.z); o[6] = bflo(v.w); o[7] = bfhi(v.w); }
__device__ __forceinline__ v4u pack8(const float (&o)[8]) { v4u v; v.x = pk2(o[0], o[1]); v.y = pk2(o[2], o[3]); v.z = pk2(o[4], o[5]); v.w = pk2(o[6], o[7]); return v; }
__device__ __forceinline__ f32x4 mfma16(bf16x8 a, bf16x8 b, f32x4 c) { return __builtin_amdgcn_mfma_f32_16x16x32_bf16(a, b, c, 0, 0, 0); }
__device__ __forceinline__ bf16x8 frag_from(const f32x4 lo, const f32x4 hi) {
    v4u v; v.x = pk2(lo[0], lo[1]); v.y = pk2(lo[2], lo[3]); v.z = pk2(hi[0], hi[1]); v.w = pk2(hi[2], hi[3]); return __builtin_bit_cast(bf16x8, v); }
__device__ __forceinline__ float wave_sum(float v) {
#pragma unroll
    for (int o = 1; o < 64; o <<= 1) v += __shfl_xor(v, o);
    return v;
}
__device__ __forceinline__ float rdlane(float v, int l) { return __builtin_bit_cast(float, __builtin_amdgcn_readlane(__builtin_bit_cast(int, v), l)); }

#define XB_TMO      128
#define XB_XCNT(j)  (256  + 64 * (j))
#define XB_XSUB(j)  (1280 + 64 * (j))
#define XB_XGEN(j)  (2304 + 64 * (j))
#define XB_TOP      3328
#define XB_TOPGEN   3392
#define XCD_BAR_WORDS 3456
#define XB_SPIN_CAP (1u << 18)

__device__ __forceinline__ unsigned xb_ld(unsigned* p)              { return __hip_atomic_load(p, __ATOMIC_RELAXED, __HIP_MEMORY_SCOPE_AGENT); }
__device__ __forceinline__ unsigned xb_add(unsigned* p, unsigned v) { return __hip_atomic_fetch_add(p, v, __ATOMIC_RELAXED, __HIP_MEMORY_SCOPE_AGENT); }
__device__ __forceinline__ unsigned xb_xcc_id() { return (unsigned)__builtin_amdgcn_s_getreg((3 << 11) | 20) & 0xFu; }
#define XB_SPIN(cond, bar) do { unsigned _sp = 0; while (cond) { __builtin_amdgcn_s_sleep(1); \
    if ((++_sp & 255u) == 0u) { if (xb_ld(&(bar)[XB_TMO])) break; if (_sp > XB_SPIN_CAP) { atomicAdd(&(bar)[XB_TMO], 1u); break; } } } } while (0)

struct XcdBarrier {
    unsigned* bar; unsigned x;
    volatile LAS unsigned* st;
};

__device__ __forceinline__ XcdBarrier xcd_barrier_post(unsigned* bar, volatile LAS unsigned* st) {
    XcdBarrier b; b.bar = bar; b.x = xb_xcc_id(); b.st = st;
    if (threadIdx.x == 0) (void)xb_add(&bar[XB_XCNT(b.x)], 1u);
    return b;
}
__device__ __forceinline__ void xcd_barrier_complete(unsigned* bar, unsigned x, unsigned& nloc, unsigned& nx) {
    const unsigned G = gridDim.x * gridDim.y * gridDim.z;
    unsigned sum, cnt, mine, sp = 0u;
    for (;;) {
        sum = 0u; cnt = 0u; mine = 0u;
#pragma unroll
        for (unsigned j = 0; j < 16; ++j) { const unsigned c = xb_ld(&bar[XB_XCNT(j)]); sum += c; cnt += (c > 0u) ? 1u : 0u; mine = (j == x) ? c : mine; }
        if (sum == G) break;
        __builtin_amdgcn_s_sleep(1);
        if ((++sp & 255u) == 0u) { if (xb_ld(&bar[XB_TMO])) break; if (sp > XB_SPIN_CAP) { atomicAdd(&bar[XB_TMO], 1u); break; } }
    }
    nloc = mine > 0u ? mine : 1u; nx = cnt > 0u ? cnt : 1u;
}

__device__ __forceinline__ void xcd_barrier(const XcdBarrier& b) {
    asm volatile("s_waitcnt vmcnt(0)" ::: "memory");
    __syncthreads();
    if (threadIdx.x == 0) {
        unsigned* bar = b.bar;
        __builtin_amdgcn_s_waitcnt(0);
        unsigned nloc = b.st[0], nx = b.st[1];
        if (nloc == 0u) { xcd_barrier_complete(bar, b.x, nloc, nx); b.st[0] = nloc; b.st[1] = nx; }
        const unsigned old = xb_add(&bar[XB_XSUB(b.x)], 1u);
        const unsigned gen = old / nloc;
        if (old + 1u == (gen + 1u) * nloc) {
            __builtin_amdgcn_fence(__ATOMIC_RELEASE, "agent");
            asm volatile("s_waitcnt vmcnt(0)" ::: "memory");
            const unsigned og = xb_add(&bar[XB_TOP], 1u);
            const unsigned tg = og / nx;
            if (og + 1u == (tg + 1u) * nx) xb_add(&bar[XB_TOPGEN], 1u);
            else XB_SPIN(xb_ld(&bar[XB_TOPGEN]) == tg, bar);
            __builtin_amdgcn_fence(__ATOMIC_ACQUIRE, "agent");
            xb_add(&bar[XB_XGEN(b.x)], 1u);
            asm volatile("s_waitcnt vmcnt(0)" ::: "memory");
        } else {
            XB_SPIN(xb_ld(&bar[XB_XGEN(b.x)]) == gen, bar);
            __builtin_amdgcn_fence(__ATOMIC_ACQUIRE, "agent");
            asm volatile("s_waitcnt vmcnt(0)" ::: "memory");
        }
    }
    __syncthreads();
}
struct Args { const float* in[21]; float* out; unsigned char* ws; int ph_lo, ph_hi, li, dbg; };
struct Frame {
    LAS unsigned char* lds; volatile LAS unsigned* MISC; gu32* ctl; unsigned char* ws;
    int tid, lane, wave, vcu, G;
};
template <class TT> __device__ __forceinline__ TT* actp(const Frame& F, size_t off) { return (TT*)(F.ws + WS_ACT + off); }

struct TItem { const float* src; bf16* dst; int ldw, ldt; };
__device__ __forceinline__ TItem titem(const float* W, int ldw, int nblk, bf16* WT, int ldt, int mode, int item) {
    const int kb = item / nblk, nb = item - kb * nblk, k0 = 64 * kb, n0 = 32 * nb;
    const int drow0 = mode == 0 ? n0 : ((n0 >> 7) * 256 + (n0 & 127) + (mode == 2 ? 128 : 0));
    TItem t; t.src = W + (size_t)k0 * ldw + n0; t.dst = WT + (size_t)drow0 * ldt + k0; t.ldw = ldw; t.ldt = ldt; return t;
}
__device__ __forceinline__ void titem_load(const TItem& t, f32x4 (&v)[8], int lane) {
#pragma unroll
    for (int i = 0; i < 8; ++i) v[i] = __builtin_nontemporal_load((const GAS f32x4*)(t.src + (size_t)(8 * i + (lane >> 3)) * t.ldw + 4 * (lane & 7)));
}
__device__ __forceinline__ void titem_to_lds(const f32x4 (&v)[8], LAS float* scr, int lane) {
#pragma unroll
    for (int i = 0; i < 8; ++i) { LAS float* d = scr + (8 * i + (lane >> 3)) * 33 + 4 * (lane & 7); d[0] = v[i][0]; d[1] = v[i][1]; d[2] = v[i][2]; d[3] = v[i][3]; }
}
__device__ __forceinline__ void titem_store(const TItem& t, LAS float* scr, int lane) {
    const int c = lane & 7;
#pragma unroll
    for (int j = 0; j < 4; ++j) { const int n = (lane >> 3) + 8 * j; const LAS float* s = scr + (8 * c) * 33 + n;
        v4u o; o.x = pk2(s[0 * 33], s[1 * 33]); o.y = pk2(s[2 * 33], s[3 * 33]); o.z = pk2(s[4 * 33], s[5 * 33]); o.w = pk2(s[6 * 33], s[7 * 33]);
        __builtin_nontemporal_store(o, (GAS v4u*)(t.dst + (size_t)n * t.ldt + 8 * c)); }
}
__device__ __forceinline__ TItem item_a(const Args& a, unsigned char* ws, int it) { return titem(a.in[1], GIN, 96, (bf16*)(ws + WS_W0T), D, 0, it); }
constexpr int NIT_A = 16 * 96;
constexpr int IB1 = 16 * 32, IB2 = 16 * 88, IB3 = IB2, IB4 = 44 * 32, IB5 = 16 * 40, IB6 = 16 * 32, NSM_B = IB1 + IB2 + IB3 + IB4 + IB5 + IB6, PER_B = 1792, NIT_B = NSM_B + NE * 3 * PER_B;
__device__ __forceinline__ TItem item_b(const Args& a, unsigned char* ws, int it) {
    int r = it;
    if (r < NSM_B) {
        if (r < IB1) return titem(a.in[6], D, 32, (bf16*)(ws + WS_WO0T), D, 0, r); r -= IB1;
        if (r < IB2) return titem(a.in[12], FF, 88, (bf16*)(ws + WS_WGU0T), D, 1, r); r -= IB2;
        if (r < IB3) return titem(a.in[13], FF, 88, (bf16*)(ws + WS_WGU0T), D, 2, r); r -= IB3;
        if (r < IB4) return titem(a.in[14], D, 32, (bf16*)(ws + WS_WD0T), FF, 0, r); r -= IB4;
        if (r < IB5) return titem(a.in[7], 1280, 40, (bf16*)(ws + WS_W1T), D, 0, r); r -= IB5;
        return titem(a.in[10], D, 32, (bf16*)(ws + WS_WO1T), D, 0, r);
    }
    r -= NSM_B;
    const int e = r / (3 * PER_B), r2 = r - e * 3 * PER_B, which = r2 / PER_B, item = r2 - which * PER_B;
    bf16* gu = (bf16*)(ws + WS_WGUT) + (size_t)e * 2 * ED * D; bf16* dn = (bf16*)(ws + WS_WDT) + (size_t)e * D * ED;
    if (which == 0) return titem(a.in[16] + (size_t)e * D * ED, ED, 112, gu, D, 1, item);
    if (which == 1) return titem(a.in[17] + (size_t)e * D * ED, ED, 112, gu, D, 2, item);
    return titem(a.in[18] + (size_t)e * ED * D, D, 32, dn, ED, 0, item);
}
#define WEIGHT_COPY_LOOP(ITEMFN, NIT, gw, NGW) do { LAS float* scr_ = (LAS float*)(F.lds + F.wave * 16384); int it_ = (gw); \
        if (it_ < (NIT)) { TItem cur_ = ITEMFN(a, F.ws, it_); f32x4 v_[8]; titem_load(cur_, v_, F.lane); \
            for (;;) { titem_to_lds(v_, scr_, F.lane); const int nx_ = it_ + (NGW); const bool more_ = nx_ < (NIT); TItem nxt_ = cur_; \
                if (more_) { nxt_ = ITEMFN(a, F.ws, nx_); titem_load(nxt_, v_, F.lane); } \
                LDS_WAIT(); asm volatile("" ::: "memory"); titem_store(cur_, scr_, F.lane); LDS_WAIT(); asm volatile("" ::: "memory"); \
                if (!more_) break; cur_ = nxt_; it_ = nx_; } } } while (0)
__device__ __forceinline__ void p0_prologue(Frame& F, const Args& a) {
    const int gw = F.vcu * NWAVES + F.wave, NGW = F.G * NWAVES;
    unsigned char* ws = F.ws;
    WEIGHT_COPY_LOOP(item_a, NIT_A, gw, NGW);
    { const GAS f32x4* xs = (const GAS f32x4*)a.in[0]; GAS v4u* xd = (GAS v4u*)a.out;
      const size_t n8 = (size_t)M * D / 8, gt = (size_t)F.vcu * 512 + F.tid, NT = (size_t)F.G * 512;
      for (size_t i = gt; i < n8; i += NT) { const f32x4 p = xs[2 * i], q = xs[2 * i + 1]; v4u o; o.x = pk2(p[0], p[1]); o.y = pk2(p[2], p[3]); o.z = pk2(q[0], q[1]); o.w = pk2(q[2], q[3]); xd[i] = o; } }
    __syncthreads();
    { LAS float* wl = (LAS float*)F.lds; const float* win = a.in[1];
      for (int i = F.tid; i < 1024 * 16; i += 512) { const int k = i >> 4, j = i & 15; wl[k * 20 + j] = win[(size_t)k * GIN + 3072 + j]; }
      __syncthreads();
      float* ablog = (float*)(ws + WS_ABLOG);
      for (int m = gw; m < M; m += NGW) {
          const float* xr = a.in[0] + (size_t)m * D;
          float acc[16];
#pragma unroll
          for (int j = 0; j < 16; ++j) acc[j] = 0.f;
#pragma unroll 4
          for (int i = 0; i < 16; ++i) { const int k = F.lane + 64 * i; const float xv = xr[k]; const LAS f32x4* wr = (const LAS f32x4*)(wl + k * 20);
#pragma unroll
              for (int q = 0; q < 4; ++q) { const f32x4 w = wr[q]; acc[4 * q] += xv * w[0]; acc[4 * q + 1] += xv * w[1]; acc[4 * q + 2] += xv * w[2]; acc[4 * q + 3] += xv * w[3]; } }
#pragma unroll
          for (int j = 0; j < 16; ++j) acc[j] = wave_sum(acc[j]);
          if (F.lane == 0) { GAS f32x4* o = (GAS f32x4*)(ablog + (size_t)m * 16);
              o[0] = (f32x4){acc[0], acc[1], acc[2], acc[3]}; o[1] = (f32x4){acc[4], acc[5], acc[6], acc[7]}; o[2] = (f32x4){acc[8], acc[9], acc[10], acc[11]}; o[3] = (f32x4){acc[12], acc[13], acc[14], acc[15]}; }
      }
      __syncthreads(); }
}
__device__ __forceinline__ void moe_weight_copies(Frame& F, const Args& a, int gw, int NGW) { WEIGHT_COPY_LOOP(item_b, NIT_B, gw, NGW); }

__device__ __forceinline__ void ln_core(f32x4 (&v)[4], const f32x4 (&g)[4], const f32x4 (&bb)[4]) {
    float s = 0.f;
#pragma unroll
    for (int j = 0; j < 4; ++j) s += (v[j][0] + v[j][1]) + (v[j][2] + v[j][3]);
    const float mean = wave_sum(s) * (1.f / D); float s2 = 0.f;
#pragma unroll
    for (int j = 0; j < 4; ++j) { v[j] = v[j] - mean; s2 += (v[j][0] * v[j][0] + v[j][1] * v[j][1]) + (v[j][2] * v[j][2] + v[j][3] * v[j][3]); }
    const float rstd = 1.f / sqrtf(wave_sum(s2) * (1.f / D) + LN_EPS);
#pragma unroll
    for (int j = 0; j < 4; ++j) v[j] = v[j] * rstd * g[j] + bb[j];
}
__device__ __forceinline__ void ln_phase(Frame& F, const float* src, const float* g, const float* b, float* dstf, bf16* dstb) {
    const int gw = F.vcu * NWAVES + F.wave, NGW = F.G * NWAVES;
    f32x4 gv[4], bv[4];
#pragma unroll
    for (int j = 0; j < 4; ++j) { gv[j] = ((const GAS f32x4*)g)[F.lane + 64 * j]; bv[j] = ((const GAS f32x4*)b)[F.lane + 64 * j]; }
    for (int m = gw; m < M; m += NGW) {
        const GAS f32x4* xr = (const GAS f32x4*)(src + (size_t)m * D) + F.lane; f32x4 v[4];
#pragma unroll
        for (int j = 0; j < 4; ++j) v[j] = xr[64 * j];
        ln_core(v, gv, bv);
        GAS f32x4* of = (GAS f32x4*)(dstf + (size_t)m * D) + F.lane; GAS v2u* ob = (GAS v2u*)(dstb + (size_t)m * D) + F.lane;
#pragma unroll
        for (int j = 0; j < 4; ++j) { of[64 * j] = v[j]; v2u o; o.x = pk2(v[j][0], v[j][1]); o.y = pk2(v[j][2], v[j][3]); ob[64 * j] = o; }
    }
}

__device__ __forceinline__ void ln3_router_phase(Frame& F, const Args& a) {
    const float* src = a.out; const float* g = a.in[19] + 2 * D; const float* b = a.in[20] + 2 * D;
    bf16* dstb = actp<bf16>(F, A_X3B);
    LAS float* wrT = (LAS float*)F.lds;
    LAS int* lcnt = (LAS int*)(F.lds + AUX_OFF);
    for (int i = F.tid; i < 8192; i += 512) { const int k = i >> 3, e = i & 7; wrT[e * 1024 + k] = a.in[15][i]; }
    f32x4 gv[4], bv[4];
#pragma unroll
    for (int j = 0; j < 4; ++j) { gv[j] = ((const GAS f32x4*)g)[F.lane + 64 * j]; bv[j] = ((const GAS f32x4*)b)[F.lane + 64 * j]; }
    gu32* gcnt = F.ctl + CW_MOE;
    int* tok_e = (int*)(F.ws + WS_TOK + TOK_E); int* tok_slot = (int*)(F.ws + WS_TOK + TOK_SLOT); float* tok_w = (float*)(F.ws + WS_TOK + TOK_W);
    for (int blk = F.vcu; blk < M / 64; blk += F.G) {
        if (F.tid < 16) lcnt[F.tid] = 0;
        __syncthreads();
        int my_e1 = 0, my_e2 = 0, my_l1 = 0, my_l2 = 0; float my_w1 = 0.f;
#pragma unroll 1
        for (int i = 0; i < 8; ++i) {
            const int m = blk * 64 + F.wave * 8 + i;
            const GAS f32x4* xr = (const GAS f32x4*)(src + (size_t)m * D) + F.lane; f32x4 v[4];
#pragma unroll
            for (int j = 0; j < 4; ++j) v[j] = xr[64 * j];
            ln_core(v, gv, bv);
            GAS v2u* ob = (GAS v2u*)(dstb + (size_t)m * D) + F.lane;
#pragma unroll
            for (int j = 0; j < 4; ++j) { v2u o; o.x = pk2(v[j][0], v[j][1]); o.y = pk2(v[j][2], v[j][3]); ob[64 * j] = o; }
            float lg[8];
#pragma unroll
            for (int e = 0; e < 8; ++e) { float s = 0.f;
#pragma unroll
                for (int j = 0; j < 4; ++j) { const f32x4 w = ((const LAS f32x4*)(wrT + e * 1024))[F.lane + 64 * j]; s += v[j][0] * w[0] + v[j][1] * w[1] + v[j][2] * w[2] + v[j][3] * w[3]; }
                lg[e] = wave_sum(s); }
            int e1 = 0; float l1 = lg[0];
#pragma unroll
            for (int e = 1; e < 8; ++e) if (lg[e] > l1) { l1 = lg[e]; e1 = e; }
            int e2 = -1; float l2 = -3.0e38f;
#pragma unroll
            for (int e = 0; e < 8; ++e) if (e != e1 && lg[e] > l2) { l2 = lg[e]; e2 = e; }
            if (e2 < 0) e2 = e1 == 0 ? 1 : 0;
            const float w1 = 1.f / (1.f + expf(l2 - l1));
            int p1 = 0, p2 = 0;
            if (F.lane == 0) { p1 = __hip_atomic_fetch_add(lcnt + e1, 1, __ATOMIC_RELAXED, __HIP_MEMORY_SCOPE_WORKGROUP); p2 = __hip_atomic_fetch_add(lcnt + e2, 1, __ATOMIC_RELAXED, __HIP_MEMORY_SCOPE_WORKGROUP); }
            p1 = __builtin_amdgcn_readfirstlane(p1); p2 = __builtin_amdgcn_readfirstlane(p2);
            if (F.lane == i) { my_e1 = e1; my_e2 = e2; my_l1 = p1; my_l2 = p2; my_w1 = w1; }
        }
        __syncthreads();
        if (F.tid < 8) lcnt[8 + F.tid] = (int)__hip_atomic_fetch_add(gcnt + 64 * F.tid, (unsigned)lcnt[F.tid], RLX_AGENT);
        __syncthreads();
        if (F.lane < 8) { const int m = blk * 64 + F.wave * 8 + F.lane;
            tok_e[2 * m] = my_e1; tok_e[2 * m + 1] = my_e2; tok_slot[2 * m] = lcnt[8 + my_e1] + my_l1; tok_slot[2 * m + 1] = lcnt[8 + my_e2] + my_l2;
            tok_w[2 * m] = my_w1; tok_w[2 * m + 1] = 1.f - my_w1; }
        __syncthreads();
    }
}
__device__ __forceinline__ void moe_offsets(Frame& F, LAS int* off  , LAS int* tile_e  ) {
    if (F.tid == 0) { int o = 0;
        for (int e = 0; e < 8; ++e) { off[e] = o; const int c = (int)__hip_atomic_load(F.ctl + CW_MOE + 64 * e, RLX_AGENT); o += (c + 255) & ~255; }
        if (o > MOE_MAXT * 256) o = MOE_MAXT * 256;
        off[8] = o; }
    __syncthreads();
    if (F.tid < MOE_MAXT) { int e = 0; const int r = F.tid * 256;
#pragma unroll
        for (int k = 1; k < 8; ++k) if (r >= off[k]) e = k;
        tile_e[F.tid] = e; }
    __syncthreads();
}
__device__ __forceinline__ void gather_phase(Frame& F) {
    LAS int* off = (LAS int*)(F.lds + AUX_OFF); LAS int* tile_e = off + 16;
    moe_offsets(F, off, tile_e);
    const int gw = F.vcu * NWAVES + F.wave, NGW = F.G * NWAVES;
    const int* tok_e = (const int*)(F.ws + WS_TOK + TOK_E); const int* tok_slot = (const int*)(F.ws + WS_TOK + TOK_SLOT); int* tok_row = (int*)(F.ws + WS_TOK + TOK_ROW);
    const bf16* xb = actp<bf16>(F, A_X3B); bf16* xg = actp<bf16>(F, A_XG);
    for (int p = gw; p < 2 * M; p += NGW) {
        const int m = p >> 1; const int e = tok_e[p], s = tok_slot[p]; const int row = off[e] + s;
        const GAS v4u* src = (const GAS v4u*)(xb + (size_t)m * D) + F.lane; GAS v4u* dst = (GAS v4u*)(xg + (size_t)row * D) + F.lane;
        const v4u v0 = src[0], v1 = src[64]; dst[0] = v0; dst[64] = v1;
        if (F.lane == 0) tok_row[p] = row;
    }
}
__device__ __forceinline__ void final_phase(Frame& F, const Args& a) {
    const int gw = F.vcu * NWAVES + F.wave, NGW = F.G * NWAVES;
    const float* g = a.in[19] + 3 * D; const float* b = a.in[20] + 3 * D;
    f32x4 gv[4], bv[4];
#pragma unroll
    for (int j = 0; j < 4; ++j) { gv[j] = ((const GAS f32x4*)g)[F.lane + 64 * j]; bv[j] = ((const GAS f32x4*)b)[F.lane + 64 * j]; }
    const int* tok_row = (const int*)(F.ws + WS_TOK + TOK_ROW); const float* tok_w = (const float*)(F.ws + WS_TOK + TOK_W);
    const bf16* y = actp<bf16>(F, A_Y);
    for (int m = gw; m < M; m += NGW) {
        const int r1 = tok_row[2 * m], r2 = tok_row[2 * m + 1]; const float w1 = tok_w[2 * m], w2 = tok_w[2 * m + 1];
        GAS f32x4* xr = (GAS f32x4*)(a.out + (size_t)m * D) + F.lane; const GAS v2u* x3 = (const GAS v2u*)(actp<bf16>(F, A_X3B) + (size_t)m * D) + F.lane; const GAS v2u* y1 = (const GAS v2u*)(y + (size_t)r1 * D) + F.lane; const GAS v2u* y2 = (const GAS v2u*)(y + (size_t)r2 * D) + F.lane;
        f32x4 v[4];
#pragma unroll
        for (int j = 0; j < 4; ++j) { const v2u xx = x3[64 * j]; const f32x4 x = (f32x4){bflo(xx.x), bfhi(xx.x), bflo(xx.y), bfhi(xx.y)}; const v2u p = y1[64 * j], q = y2[64 * j];
            v[j][0] = ALPHA * x[0] + w1 * bflo(p.x) + w2 * bflo(q.x); v[j][1] = ALPHA * x[1] + w1 * bfhi(p.x) + w2 * bfhi(q.x);
            v[j][2] = ALPHA * x[2] + w1 * bflo(p.y) + w2 * bflo(q.y); v[j][3] = ALPHA * x[3] + w1 * bfhi(p.y) + w2 * bfhi(q.y); }
        ln_core(v, gv, bv);
#pragma unroll
        for (int j = 0; j < 4; ++j) xr[64 * j] = v[j];
    }
}
struct MoeOrder {
    int t_lo, nT, nN, nwg, G, c; const LAS int* tile_e;
    __device__ __forceinline__ void init(int t_lo_, int t_hi_, int nN_, int G_, int c_, const LAS int* te) { t_lo = t_lo_; nT = t_hi_ > t_lo_ ? t_hi_ - t_lo_ : 0; nN = nN_; nwg = nT * nN; G = G_; c = c_; tile_e = te; }
    __device__ __forceinline__ bool next(int i, pg8::Unit& u) const {
        const long L = (long)i * G + c; if (L >= nwg) return false;
        int wgid = (int)L; { const int q = nwg / 8, r = nwg % 8, xcd = wgid % 8, o = wgid / 8; wgid = (xcd < r ? xcd * (q + 1) : r * (q + 1) + (xcd - r) * q) + o; }
        const int nig = 8 * nN, gid = wgid / nig, fm = gid * 8, gsz = (nT - fm) < 8 ? (nT - fm) : 8;
        const int pm = t_lo + fm + ((wgid % nig) % gsz), pnl = (wgid % nig) / gsz;
        u.pm = pm; u.pn = tile_e[pm] * nN + pnl; return true;
    }
    __device__ __forceinline__ void a_ready(const pg8::Unit&) const {}
    __device__ __forceinline__ void done(const pg8::Unit&) const {}
    bool segmented; pg8::HSeg seg;
    __device__ __forceinline__ const char* a_tile(const pg8::Gemm& g, const pg8::Unit& u, size_t tstep) const { return segmented ? (const char*)seg.tile(u.pm) : (const char*)g.A + (size_t)u.pm * tstep; }
};
constexpr int L_QS = 0, L_KS = 17408, L_KG = 34816, L_VB = 52224, L_A = 69632, L_TB = 87040, L_T11T = 96256, L_G = 98816;
__device__ __forceinline__ float fexp(float x) { return __builtin_amdgcn_exp2f(x * LOG2E); }
__device__ __forceinline__ void load_row8(const bf16* base, int t, float (&o)[8]) {
    if (t >= 0) { const v4u v = *(const GAS v4u*)(base + (size_t)t * 1024); unpack8(v, o); }
    else {
#pragma unroll
        for (int e = 0; e < 8; ++e) o[e] = 0.f; }
}
__device__ __forceinline__ bf16x8 gather_col8(const LAS unsigned char* p) {
    unsigned e[8];
#pragma unroll
    for (int j = 0; j < 8; ++j) e[j] = *(const LAS bf16*)(p + j * 272);
    v4u v; v.x = e[0] | (e[1] << 16); v.y = e[2] | (e[3] << 16); v.z = e[4] | (e[5] << 16); v.w = e[6] | (e[7] << 16);
    return __builtin_bit_cast(bf16x8, v);
}
__device__ __forceinline__ void cl_phase(Frame& F, const Args& a) {
    const bf16* QK = actp<bf16>(F, A_QK); const bf16* V = actp<bf16>(F, A_V);
    bf16* U = actp<bf16>(F, A_U); bf16* WP = actp<bf16>(F, A_WP); bf16* QD = actp<bf16>(F, A_QD); bf16* KDT = actp<bf16>(F, A_KDT); bf16* AQK = actp<bf16>(F, A_AQK);
    const float* ablog = (const float*)(F.ws + WS_ABLOG); float* DL = (float*)(F.ws + WS_TOK + TOK_DL);
    const float* conv_w = a.in[2]; const float* a_log = a.in[3]; const float* dt_bias = a.in[4];
    LAS unsigned char* L = F.lds;
    LAS float* gcs = (LAS float*)(L + L_G); LAS float* betas = gcs + 64; LAS float* egs = gcs + 128; LAS float* egls = gcs + 192; LAS float* As = (LAS float*)(L + L_A);
    v4u prow[11]; f32x4 pcw[8]; float pbl = 0.f, pal = 0.f;
#define CL_PREF(uu) do { const int b_ = (uu) >> 10, n_ = ((uu) >> 3) & 127, h_ = (uu) & 7, kh_ = h_ >> 1; const int l_ = F.lane, fr_ = l_ & 15, fq_ = l_ >> 4; \
        const int mrow_ = b_ * T + n_ * 64 + l_; pbl = ablog[(size_t)mrow_ * 16 + h_]; pal = ablog[(size_t)mrow_ * 16 + 8 + h_]; \
        if (fq_ < 3) { const int tb_ = n_ * 64 + 8 * F.wave; const bf16* src_; int ch_; \
            if (fq_ == 0) { src_ = QK + (size_t)b_ * T * 1024 + kh_ * 128 + 8 * fr_; ch_ = kh_ * 128 + 8 * fr_; } \
            else if (fq_ == 1) { src_ = QK + (size_t)b_ * T * 1024 + 512 + kh_ * 128 + 8 * fr_; ch_ = 512 + kh_ * 128 + 8 * fr_; } \
            else { src_ = V + (size_t)b_ * T * 1024 + h_ * 128 + 8 * fr_; ch_ = 1024 + h_ * 128 + 8 * fr_; } \
            _Pragma("unroll") for (int j_ = 0; j_ < 4; ++j_) { pcw[2 * j_] = *(const GAS f32x4*)(conv_w + j_ * 2048 + ch_); pcw[2 * j_ + 1] = *(const GAS f32x4*)(conv_w + j_ * 2048 + ch_ + 4); } \
            _Pragma("unroll") for (int r_ = 0; r_ < 11; ++r_) { const int t_ = tb_ - 3 + r_; prow[r_] = t_ >= 0 ? *(const GAS v4u*)(src_ + (size_t)t_ * 1024) : (v4u){0u, 0u, 0u, 0u}; } } } while (0)
    if (F.vcu < BATCH * NCH * GH) CL_PREF(F.vcu);
    for (int u = F.vcu; u < BATCH * NCH * GH; u += F.G) {
        int lane_o = F.lane, wave_o = F.wave; asm volatile("" : "+v"(lane_o), "+s"(wave_o));
        const int lane = lane_o, w = wave_o, fr = lane & 15, fq = lane >> 4;
        const int b = u >> 10, n = (u >> 3) & 127, h = u & 7, kh = h >> 1;
        const size_t uidx = (size_t)(b * GH + h) * NCH + n;
        float beta, gc, glast;
        { const float bl = pbl, al = pal;
          beta = 1.f / (1.f + expf(-bl));
          const float xx = al + dt_bias[h]; const float sp = fmaxf(xx, 0.f) + log1pf(expf(-fabsf(xx)));
          gc = -expf(a_log[h]) * sp;
#pragma unroll
          for (int d = 1; d < 64; d <<= 1) { const float t = __shfl_up(gc, d); if (lane >= d) gc += t; }
          glast = rdlane(gc, 63);
          if (w == 0) { gcs[lane] = gc; betas[lane] = beta; egs[lane] = fexp(gc); egls[lane] = fexp(glast - gc); if (lane == 0) DL[uidx] = fexp(glast); } }
        if (fq < 3) {
            float cw[4][8];
#pragma unroll
            for (int j = 0; j < 4; ++j) { const f32x4 p = pcw[2 * j], q = pcw[2 * j + 1];
                cw[j][0] = p[0]; cw[j][1] = p[1]; cw[j][2] = p[2]; cw[j][3] = p[3]; cw[j][4] = q[0]; cw[j][5] = q[1]; cw[j][6] = q[2]; cw[j][7] = q[3]; }
            float x0[8], x1[8], x2[8], x3[8];
            unpack8(prow[0], x0); unpack8(prow[1], x1); unpack8(prow[2], x2);
#pragma unroll
            for (int i = 0; i < 8; ++i) {
                unpack8(prow[3 + i], x3);
                float o[8]; float ss = 0.f;
#pragma unroll
                for (int e = 0; e < 8; ++e) { const float c = cw[0][e] * x0[e] + cw[1][e] * x1[e] + cw[2][e] * x2[e] + cw[3][e] * x3[e]; o[e] = pg8::fast_silu(c); ss += o[e] * o[e]; }
#pragma unroll
                for (int e = 0; e < 8; ++e) { x0[e] = x1[e]; x1[e] = x2[e]; x2[e] = x3[e]; }
                ss += __shfl_xor(ss, 1); ss += __shfl_xor(ss, 2); ss += __shfl_xor(ss, 4); ss += __shfl_xor(ss, 8);
                const int r = 8 * w + i; const float br = rdlane(beta, r), gr = rdlane(gc, r);
                const float rs = 1.f / sqrtf(ss + GDN_EPS);
                if (fq == 0) {
#pragma unroll
                    for (int e = 0; e < 8; ++e) o[e] *= rs * 0.08838834764831845f;
                    *(LAS v4u*)(L + L_QS + r * 272 + fr * 16) = pack8(o);
                } else if (fq == 1) {
#pragma unroll
                    for (int e = 0; e < 8; ++e) o[e] *= rs;
                    *(LAS v4u*)(L + L_KS + r * 272 + fr * 16) = pack8(o);
                    const float sc = br * fexp(gr);
#pragma unroll
                    for (int e = 0; e < 8; ++e) o[e] *= sc;
                    *(LAS v4u*)(L + L_KG + r * 272 + fr * 16) = pack8(o);
                } else {
#pragma unroll
                    for (int e = 0; e < 8; ++e) o[e] *= br;
                    *(LAS v4u*)(L + L_VB + r * 272 + fr * 16) = pack8(o);
                }
            }
        }
        if (u + F.G < BATCH * NCH * GH) CL_PREF(u + F.G);
        WG_BAR_LDS();
        {
            const bool isqk = w >= 4; const int mt = w & 3;
            bf16x8 af[4];
#pragma unroll
            for (int ks = 0; ks < 4; ++ks) af[ks] = *(const LAS bf16x8*)(L + L_KS + (16 * mt + fr) * 272 + (32 * ks + 8 * fq) * 2);
#pragma unroll
            for (int nt = 0; nt < 4; ++nt) {
                f32x4 c = (f32x4){0.f, 0.f, 0.f, 0.f};
                const bool need = isqk ? (mt <= nt) : (nt <= mt);
                if (need) {
#pragma unroll
                    for (int ks = 0; ks < 4; ++ks) { const bf16x8 bfr = *(const LAS bf16x8*)(L + (isqk ? L_QS : L_KS) + (16 * nt + fr) * 272 + (32 * ks + 8 * fq) * 2); c = mfma16(af[ks], bfr, c); }
                }
                const int col = 16 * nt + fr;
                if (!isqk) {
                    const float gj = gcs[col];
#pragma unroll
                    for (int r = 0; r < 4; ++r) { const int i = 16 * mt + 4 * fq + r; const float v = (col < i) ? betas[i] * c[r] * fexp(gcs[i] - gj) : 0.f; As[i * 68 + col] = v; }
                } else {
                    const float gi = gcs[col]; float o4[4];
#pragma unroll
                    for (int r = 0; r < 4; ++r) { const int s = 16 * mt + 4 * fq + r; o4[r] = (s <= col) ? c[r] * fexp(gi - gcs[s]) : 0.f; }
                    v2u o; o.x = pk2(o4[0], o4[1]); o.y = pk2(o4[2], o4[3]);
                    *(GAS v2u*)(AQK + uidx * 4096 + col * 64 + 32 * (mt >> 1) + 8 * fq + 4 * (mt & 1)) = o;
                }
            }
        }
        WG_BAR_LDS();
        if (w == 0) {
            const int hl = lane >> 5, cl = lane & 31;
            const LAS float* Ab = As + hl * (32 * 68 + 32);
            float x[32]; float fcl = (float)cl; asm volatile("" : "+v"(fcl));
#pragma unroll
            for (int i = 0; i < 32; ++i) x[i] = 0.f;
            f32x4 ra[8], rb[8];
#pragma unroll
            for (int q = 0; q < 8; ++q) { ra[q] = (f32x4){0.f, 0.f, 0.f, 0.f}; rb[q] = (f32x4){0.f, 0.f, 0.f, 0.f}; }
#pragma unroll
            for (int i = 0; i < 32; ++i) {
                if (i + 1 < 32) {
#pragma unroll
                    for (int q = 0; 4 * q < i + 1; ++q) { if ((i & 1) == 0) rb[q] = *(const LAS f32x4*)(Ab + (i + 1) * 68 + 4 * q); else ra[q] = *(const LAS f32x4*)(Ab + (i + 1) * 68 + 4 * q); }
                }
                float s0 = 0.f, s1 = 0.f, s2 = 0.f, s3 = 0.f;
#pragma unroll
                for (int q = 0; 4 * q < i; ++q) { const f32x4 av = (i & 1) == 0 ? ra[q] : rb[q]; s0 += av[0] * x[4 * q]; s1 += av[1] * x[4 * q + 1]; s2 += av[2] * x[4 * q + 2]; s3 += av[3] * x[4 * q + 3]; }
                x[i] = fmaxf(0.f, 1.f - fabsf(fcl - (float)i)) - ((s0 + s1) + (s2 + s3));
                asm volatile("" : "+v"(x[i]) :: "memory");
            }
#pragma unroll
            for (int i = 0; i < 32; ++i) *(LAS bf16*)(L + L_TB + (32 * hl + i) * 144 + (32 * hl + cl) * 2) = (bf16)f2bf(x[i]);
            if (hl == 0) {
#pragma unroll
                for (int q = 0; q < 4; ++q) { v4u o; o.x = pk2(x[8 * q], x[8 * q + 1]); o.y = pk2(x[8 * q + 2], x[8 * q + 3]); o.z = pk2(x[8 * q + 4], x[8 * q + 5]); o.w = pk2(x[8 * q + 6], x[8 * q + 7]);
                    *(LAS v4u*)(L + L_T11T + cl * 80 + q * 16) = o; }
            }
#pragma unroll
            for (int q = 0; q < 2; ++q) { const int p = lane + 64 * q; *(LAS v4u*)(L + L_TB + (p >> 2) * 144 + 64 + (p & 3) * 16) = (v4u){0u, 0u, 0u, 0u}; }
            LDS_WAIT(); asm volatile("" ::: "memory");
            f32x4 Y[2][2];
#pragma unroll
            for (int it = 0; it < 2; ++it) { const LAS f32x4* ar = (const LAS f32x4*)(As + (32 + 16 * it + fr) * 68 + 8 * fq); const bf16x8 afr = frag_from(ar[0], ar[1]);
#pragma unroll
                for (int ct = 0; ct < 2; ++ct) { const bf16x8 bfr = *(const LAS bf16x8*)(L + L_T11T + (16 * ct + fr) * 80 + fq * 16); Y[it][ct] = mfma16(afr, bfr, (f32x4){0.f, 0.f, 0.f, 0.f}); } }
#pragma unroll
            for (int ct = 0; ct < 2; ++ct) { const bf16x8 afr = frag_from(Y[0][ct], Y[1][ct]);
#pragma unroll
                for (int it = 0; it < 2; ++it) { const LAS unsigned char* tp = L + L_TB + (32 + 16 * it + fr) * 144 + (32 + 4 * fq) * 2;
                    const v2u lo = *(const LAS v2u*)tp, hi = *(const LAS v2u*)(tp + 32); v4u bv; bv.x = lo.x; bv.y = lo.y; bv.z = hi.x; bv.w = hi.y;
                    const f32x4 t = mfma16(afr, __builtin_bit_cast(bf16x8, bv), (f32x4){0.f, 0.f, 0.f, 0.f});
                    v2u o; o.x = pk2(-t[0], -t[1]); o.y = pk2(-t[2], -t[3]);
                    *(LAS v2u*)(L + L_TB + (32 + 16 * it + fr) * 144 + (16 * ct + 4 * fq) * 2) = o; } }
        } else {
            const int idx = (w - 1) * 64 + lane;
            for (int p = idx; p < 1024; p += 448) {
                const int i = p >> 4, c16 = p & 15, d0 = 32 * (c16 >> 2) + 4 * (c16 & 3);
                const v2u lo = *(const LAS v2u*)(L + L_QS + i * 272 + d0 * 2), hi = *(const LAS v2u*)(L + L_QS + i * 272 + (d0 + 16) * 2);
                const float eg = egs[i];
                v4u o; o.x = pk2(bflo(lo.x) * eg, bfhi(lo.x) * eg); o.y = pk2(bflo(lo.y) * eg, bfhi(lo.y) * eg); o.z = pk2(bflo(hi.x) * eg, bfhi(hi.x) * eg); o.w = pk2(bflo(hi.y) * eg, bfhi(hi.y) * eg);
                *(GAS v4u*)(QD + uidx * 8192 + i * 128 + c16 * 8) = o;
            }
            for (int p = idx; p < 1024; p += 448) {
                const int dk = p >> 3, c8 = p & 7, t0 = 32 * (c8 >> 2) + 4 * (c8 & 3);
                float o[8];
#pragma unroll
                for (int j = 0; j < 8; ++j) { const int tk = t0 + 16 * (j >> 2) + (j & 3); o[j] = bf2f(*(const LAS bf16*)(L + L_KS + tk * 272 + dk * 2)) * egls[tk]; }
                *(GAS v4u*)(KDT + uidx * 8192 + dk * 64 + c8 * 8) = pack8(o);
            }
        }
        WG_BAR_LDS();
        {
            bf16x8 tf[4][2];
#pragma unroll
            for (int t = 0; t < 4; ++t)
#pragma unroll
                for (int ks = 0; ks < 2; ++ks) tf[t][ks] = *(const LAS bf16x8*)(L + L_TB + (16 * t + fr) * 144 + (32 * ks + 8 * fq) * 2);
            bf16x8 vb[2], kg[2];
#pragma unroll
            for (int ks = 0; ks < 2; ++ks) { vb[ks] = gather_col8(L + L_VB + (32 * ks + 8 * fq) * 272 + (16 * w + fr) * 2); kg[ks] = gather_col8(L + L_KG + (32 * ks + 8 * fq) * 272 + (16 * w + fr) * 2); }
#pragma unroll
            for (int t = 0; t < 4; ++t) {
                f32x4 cu = (f32x4){0.f, 0.f, 0.f, 0.f}, cwt = (f32x4){0.f, 0.f, 0.f, 0.f};
#pragma unroll
                for (int ks = 0; ks < 2; ++ks) { cu = mfma16(tf[t][ks], vb[ks], cu); cwt = mfma16(kg[ks], tf[t][ks], cwt); }
                v2u ou; ou.x = pk2(cu[0], cu[1]); ou.y = pk2(cu[2], cu[3]);
                *(GAS v2u*)(U + uidx * 8192 + w * 1024 + t * 256 + lane * 4) = ou;
                v2u ow; ow.x = pk2(cwt[0], cwt[1]); ow.y = pk2(cwt[2], cwt[3]);
                *(GAS v2u*)(WP + uidx * 8192 + (16 * t + fr) * 128 + 32 * (w >> 1) + 8 * fq + 4 * (w & 1)) = ow;
            }
        }
        WG_BAR_LDS();
    }
}
constexpr int SC_W = 0, SC_KDT = 17408, SC_U = 35840, SC_BUF = 44032;
#ifdef PROBE_SCAN
#define VN_BASE(F, o) ((bf16*)(o) + (size_t)16 * 1024 * 1024)
#else
#define VN_BASE(F, o) actp<bf16>(F, A_U)
#endif
__device__ __forceinline__ void scan_phase(Frame& F, int item, float* vnout) {
    const int bh = item >> 1, j2 = item & 1; const int lane = F.lane, w = F.wave, fr = lane & 15, fq = lane >> 4;
    bf16* U = actp<bf16>(F, A_U) + (size_t)bh * NCH * 8192; const bf16* WP = actp<bf16>(F, A_WP) + (size_t)bh * NCH * 8192;
    const bf16* KDT = actp<bf16>(F, A_KDT) + (size_t)bh * NCH * 8192; bf16* SST = actp<bf16>(F, A_S) + (size_t)bh * NCH * 16384;
    const float* DL = (const float*)(F.ws + WS_TOK + TOK_DL) + (size_t)bh * NCH;
    bf16* VNO = VN_BASE(F, vnout) + (size_t)bh * NCH * 8192;
    LAS unsigned char* L = F.lds;
    LAS float* dls = (LAS float*)(L + AUX_OFF); if (F.tid < NCH) dls[F.tid] = DL[F.tid];
    if (w >= 4) {
        const int t2 = F.tid - 256;
        v4u s0[10], s1[10], s2[10], s3[10];
#define SCL_LOAD(pre, nn) do { const int n_ = (nn) < NCH ? (nn) : NCH - 1; const v4u* pw = (const v4u*)(WP + (size_t)n_ * 8192), *pk = (const v4u*)(KDT + (size_t)n_ * 8192), *pu = (const v4u*)(U + (size_t)n_ * 8192 + j2 * 4096); \
        _Pragma("unroll") for (int i = 0; i < 4; ++i) { pre[i] = pw[t2 + 256 * i]; pre[4 + i] = pk[t2 + 256 * i]; } pre[8] = pu[t2]; pre[9] = pu[t2 + 256]; } while (0)
#define SCL_STORE(pre, buf) do { LAS unsigned char* B_ = L + (buf) * SC_BUF; \
        _Pragma("unroll") for (int i = 0; i < 4; ++i) { const int p_ = t2 + 256 * i; *(LAS v4u*)(B_ + SC_W + (p_ >> 4) * 272 + (p_ & 15) * 16) = pre[i]; *(LAS v4u*)(B_ + SC_KDT + (p_ >> 3) * 144 + (p_ & 7) * 16) = pre[4 + i]; } \
        *(LAS v4u*)(B_ + SC_U + t2 * 16) = pre[8]; *(LAS v4u*)(B_ + SC_U + (t2 + 256) * 16) = pre[9]; } while (0)
        SCL_LOAD(s0, 0); SCL_STORE(s0, 0); SCL_LOAD(s1, 1); SCL_LOAD(s2, 2); SCL_LOAD(s3, 3);
        WG_BAR_LDS();
#pragma unroll 1
        for (int n = 0; n < NCH; n += 4) {
            SCL_LOAD(s0, n + 4); SCL_STORE(s1, 1); WG_BAR_LDS();
            SCL_LOAD(s1, n + 5); SCL_STORE(s2, 0); WG_BAR_LDS();
            SCL_LOAD(s2, n + 6); SCL_STORE(s3, 1); WG_BAR_LDS();
            SCL_LOAD(s3, n + 7); SCL_STORE(s0, 0); WG_BAR_LDS();
        }
#undef SCL_LOAD
#undef SCL_STORE
    } else {
        const int sl = 4 * j2 + w;
        f32x4 S[8];
#pragma unroll
        for (int i = 0; i < 8; ++i) S[i] = (f32x4){0.f, 0.f, 0.f, 0.f};
#define SC_STEP(n, buf) do { LAS unsigned char* Bp = L + (buf) * SC_BUF; \
            const float dl = dls[n]; \
            bf16x8 Sb[4]; \
            _Pragma("unroll") for (int ks = 0; ks < 4; ++ks) { Sb[ks] = frag_from(S[2 * ks], S[2 * ks + 1]); *(GAS bf16x8*)(SST + (size_t)(n) * 16384 + sl * 2048 + ks * 512 + lane * 8) = Sb[ks]; } \
            f32x4 vn[4]; \
            _Pragma("unroll") for (int mt = 0; mt < 4; ++mt) { \
                f32x4 p = (f32x4){0.f, 0.f, 0.f, 0.f}; \
                _Pragma("unroll") for (int ks = 0; ks < 4; ++ks) { const bf16x8 aw = *(const LAS bf16x8*)(Bp + SC_W + (16 * mt + fr) * 272 + (32 * ks + 8 * fq) * 2); p = mfma16(aw, Sb[ks], p); } \
                const v2u uu = *(const LAS v2u*)(Bp + SC_U + w * 2048 + mt * 512 + lane * 8); \
                vn[mt] = (f32x4){bflo(uu.x) - p[0], bfhi(uu.x) - p[1], bflo(uu.y) - p[2], bfhi(uu.y) - p[3]}; \
            } \
            bf16x8 Vb[2]; \
            _Pragma("unroll") for (int ks = 0; ks < 2; ++ks) { Vb[ks] = frag_from(vn[2 * ks], vn[2 * ks + 1]); *(GAS bf16x8*)(VNO + (size_t)(n) * 8192 + sl * 1024 + ks * 512 + lane * 8) = Vb[ks]; } \
            _Pragma("unroll") for (int mt = 0; mt < 8; ++mt) { f32x4 s = S[mt] * dl; \
                _Pragma("unroll") for (int ks = 0; ks < 2; ++ks) { const bf16x8 ak = *(const LAS bf16x8*)(Bp + SC_KDT + (16 * mt + fr) * 144 + (32 * ks + 8 * fq) * 2); s = mfma16(ak, Vb[ks], s); } \
                S[mt] = s; } \
        } while (0)
        WG_BAR_LDS();
#pragma unroll 1
        for (int n = 0; n < NCH; n += 2) {
            SC_STEP(n, 0); WG_BAR_LDS();
            SC_STEP(n + 1, 1); WG_BAR_LDS();
        }
#undef SC_STEP
    }
}
constexpr int GO_QD = 0, GO_AQK = 17408, GO_Z = 26624, GO_BUF = 44032, GO_OG = 2 * GO_BUF;
__device__ __forceinline__ void gdn_out_phase(Frame& F, const Args& a) {
    const int lane = F.lane, w = F.wave, fr = lane & 15, fq = lane >> 4, tid = F.tid;
    LAS unsigned char* L = F.lds; LAS float* part = (LAS float*)(L + AUX_OFF);
    const float nw = a.in[5][16 * w + fr];
    v4u pre[5]; bf16x8 SbN[4], VbN[2], Sb[4], Vb[2];
#define GO_LOAD(uu) do { const int bh_ = (uu) >> 7, n_ = (uu) & 127, b_ = bh_ >> 3, h_ = bh_ & 7; \
        const v4u* pq = (const v4u*)(actp<bf16>(F, A_QD) + (size_t)(uu) * 8192); const v4u* pa = (const v4u*)(actp<bf16>(F, A_AQK) + (size_t)(uu) * 4096); \
        const bf16* zb = actp<bf16>(F, A_Z) + (size_t)(b_ * T + n_ * 64) * 1024 + h_ * 128; \
        pre[0] = pq[tid]; pre[1] = pq[tid + 512]; pre[2] = pa[tid]; \
        pre[3] = *(const GAS v4u*)(zb + (size_t)(tid >> 4) * 1024 + (tid & 15) * 8); pre[4] = *(const GAS v4u*)(zb + (size_t)(32 + (tid >> 4)) * 1024 + (tid & 15) * 8); \
        const bf16* sst = actp<bf16>(F, A_S) + (size_t)(uu) * 16384 + w * 2048; const bf16* vn = VN_BASE(F, a.out) + (size_t)(uu) * 8192 + w * 1024; \
        _Pragma("unroll") for (int ks = 0; ks < 4; ++ks) SbN[ks] = *(const GAS bf16x8*)(sst + ks * 512 + lane * 8); \
        _Pragma("unroll") for (int ks = 0; ks < 2; ++ks) VbN[ks] = *(const GAS bf16x8*)(vn + ks * 512 + lane * 8); } while (0)
#define GO_STORE(buf) do { LAS unsigned char* B_ = L + (buf) * GO_BUF; \
        *(LAS v4u*)(B_ + GO_QD + (tid >> 4) * 272 + (tid & 15) * 16) = pre[0]; *(LAS v4u*)(B_ + GO_QD + (32 + (tid >> 4)) * 272 + (tid & 15) * 16) = pre[1]; \
        *(LAS v4u*)(B_ + GO_AQK + (tid >> 3) * 144 + (tid & 7) * 16) = pre[2]; \
        *(LAS v4u*)(B_ + GO_Z + (tid >> 4) * 272 + (tid & 15) * 16) = pre[3]; *(LAS v4u*)(B_ + GO_Z + (32 + (tid >> 4)) * 272 + (tid & 15) * 16) = pre[4]; } while (0)
    int u = F.vcu, it = 0;
    if (u < BATCH * GH * NCH) { GO_LOAD(u); GO_STORE(0); }
    WG_BAR_LDS();
    for (; u < BATCH * GH * NCH; u += F.G, ++it) {
        const int buf = it & 1; LAS unsigned char* Bp = L + buf * GO_BUF;
        const int bh = u >> 7, n = u & 127, b = bh >> 3, h = bh & 7;
#pragma unroll
        for (int ks = 0; ks < 4; ++ks) Sb[ks] = SbN[ks];
#pragma unroll
        for (int ks = 0; ks < 2; ++ks) Vb[ks] = VbN[ks];
        const int un = u + F.G; const bool more = un < BATCH * GH * NCH;
        if (more) GO_LOAD(un);
        f32x4 O[4];
#pragma unroll
        for (int mt = 0; mt < 4; ++mt) {
            f32x4 o = (f32x4){0.f, 0.f, 0.f, 0.f};
#pragma unroll
            for (int ks = 0; ks < 4; ++ks) { const bf16x8 aq = *(const LAS bf16x8*)(Bp + GO_QD + (16 * mt + fr) * 272 + (32 * ks + 8 * fq) * 2); o = mfma16(aq, Sb[ks], o); }
#pragma unroll
            for (int ks = 0; ks < 2; ++ks) { const bf16x8 aa = *(const LAS bf16x8*)(Bp + GO_AQK + (16 * mt + fr) * 144 + (32 * ks + 8 * fq) * 2); o = mfma16(aa, Vb[ks], o); }
            O[mt] = o;
        }
#pragma unroll
        for (int mt = 0; mt < 4; ++mt)
#pragma unroll
            for (int r = 0; r < 4; ++r) { float q = O[mt][r] * O[mt][r]; q += __shfl_xor(q, 1); q += __shfl_xor(q, 2); q += __shfl_xor(q, 4); q += __shfl_xor(q, 8);
                if (fr == 0) part[w * 64 + 16 * mt + 4 * fq + r] = q; }
        WG_BAR_LDS();
        if (tid < 64) { float q = 0.f;
#pragma unroll
            for (int ww = 0; ww < 8; ++ww) q += part[ww * 64 + tid];
            part[512 + tid] = __builtin_amdgcn_rsqf(q * (1.f / 128.f) + GDN_EPS); }
        WG_BAR_LDS();
#pragma unroll
        for (int mt = 0; mt < 4; ++mt)
#pragma unroll
            for (int r = 0; r < 4; ++r) { const int tk = 16 * mt + 4 * fq + r;
                const float rs = part[512 + tk]; const float zz = bf2f(*(const LAS bf16*)(Bp + GO_Z + tk * 272 + (16 * w + fr) * 2));
                *(LAS bf16*)(L + GO_OG + tk * 272 + (16 * w + fr) * 2) = (bf16)f2bf(O[mt][r] * rs * nw * pg8::fast_silu(zz)); }
        if (more) GO_STORE(buf ^ 1);
        WG_BAR_LDS();
        { bf16* og = actp<bf16>(F, A_OG) + (size_t)(b * T + n * 64) * 1024 + h * 128;
          const v4u o0 = *(const LAS v4u*)(L + GO_OG + (tid >> 4) * 272 + (tid & 15) * 16), o1 = *(const LAS v4u*)(L + GO_OG + (32 + (tid >> 4)) * 272 + (tid & 15) * 16);
          *(GAS v4u*)(og + (size_t)(tid >> 4) * 1024 + (tid & 15) * 8) = o0; *(GAS v4u*)(og + (size_t)(32 + (tid >> 4)) * 1024 + (tid & 15) * 8) = o1; }
        WG_BAR_LDS();
    }
#undef GO_LOAD
#undef GO_STORE
}
constexpr int AT_K = 0, AT_VT = 27648, AT_VT_LD = 432, AT_BIAS = AUX_OFF, AT_SINK = AUX_OFF + 8192;
__device__ __forceinline__ void attn_phase(Frame& F, const Args& a) {
    const bf16* Q = actp<bf16>(F, A_Q1); const bf16* K = actp<bf16>(F, A_K1); const bf16* V = actp<bf16>(F, A_V1); bf16* OB = actp<bf16>(F, A_OB);
    LAS unsigned char* L = F.lds; LAS float* bias2 = (LAS float*)(L + AT_BIAS); LAS float* sink2 = (LAS float*)(L + AT_SINK);
    const int lane = F.lane, w = F.wave, fr = lane & 15, fq = lane >> 4, tid = F.tid;
    for (int i = tid; i < 16 * 128; i += 512) { const int hh = i >> 7, dist = i & 127; int bk = dist;
        if (dist >= 16) { bk = 16 + (int)(logf((float)dist / 16.f) / 2.0794415416798357f * 16.f); bk = bk < 31 ? bk : 31; }
        bias2[i] = a.in[11][bk * 16 + hh] * LOG2E; }
    if (tid < 16) sink2[tid] = a.in[9][tid] * LOG2E;
    WG_BAR_LDS();
    for (int u = F.vcu; u < BATCH * 2 * (T / 64); u += F.G) {
        const int b = u >> 8, kvh = (u >> 7) & 1, qt = u & 127, t0 = qt * 64, ts = t0 - 128;
        for (int p = tid; p < 1536; p += 512) { const int j = p >> 3, c = p & 7; v4u kv = (v4u){0u, 0u, 0u, 0u}, vv = (v4u){0u, 0u, 0u, 0u};
            if (ts + j >= 0) { const size_t row = (size_t)(b * T + ts + j) * 128 + kvh * 64 + 8 * c; kv = *(const GAS v4u*)(K + row); vv = *(const GAS v4u*)(V + row); }
            *(LAS v4u*)(L + AT_K + j * 144 + c * 16) = kv;
            LAS bf16* vt = (LAS bf16*)(L + AT_VT + (8 * c) * AT_VT_LD + j * 2);
            vt[0 * (AT_VT_LD / 2)] = (bf16)(vv.x & 0xffff); vt[1 * (AT_VT_LD / 2)] = (bf16)(vv.x >> 16); vt[2 * (AT_VT_LD / 2)] = (bf16)(vv.y & 0xffff); vt[3 * (AT_VT_LD / 2)] = (bf16)(vv.y >> 16);
            vt[4 * (AT_VT_LD / 2)] = (bf16)(vv.z & 0xffff); vt[5 * (AT_VT_LD / 2)] = (bf16)(vv.z >> 16); vt[6 * (AT_VT_LD / 2)] = (bf16)(vv.w & 0xffff); vt[7 * (AT_VT_LD / 2)] = (bf16)(vv.w >> 16); }
        for (int p = tid; p < 64 * 16; p += 512) { const int d = p >> 4, j = 192 + (p & 15); *(LAS bf16*)(L + AT_VT + d * AT_VT_LD + j * 2) = 0; }
        WG_BAR_LDS();
        const int h = kvh * 8 + w; const float sk = sink2[h];
#pragma unroll 1
        for (int mt = 0; mt < 4; ++mt) {
            bf16x8 qf[2];
#pragma unroll
            for (int ks = 0; ks < 2; ++ks) qf[ks] = *(const GAS bf16x8*)(Q + (size_t)(b * T + t0 + 16 * mt + fr) * 1024 + h * 64 + 32 * ks + 8 * fq);
            f32x4 s[10]; float mx = sk;
#pragma unroll
            for (int nl = 0; nl < 10; ++nl) {
                f32x4 c = (f32x4){0.f, 0.f, 0.f, 0.f}; const int nt = mt + nl;
                if (nt < 12) {
#pragma unroll
                    for (int ks = 0; ks < 2; ++ks) { const bf16x8 kf = *(const LAS bf16x8*)(L + AT_K + (16 * nt + fr) * 144 + (32 * ks + 8 * fq) * 2); c = mfma16(kf, qf[ks], c); }
                }
#pragma unroll
                for (int r = 0; r < 4; ++r) { const int dist = 128 - 16 * nl + fr - 4 * fq - r, j = 16 * nt + 4 * fq + r;
                    const bool ok = (dist >= 0) && (dist < 128) && (ts + j >= 0) && (nt < 12);
                    const float v = ok ? c[r] + bias2[h * 128 + (dist & 127)] : -INFINITY; c[r] = v; mx = fmaxf(mx, v); }
                s[nl] = c;
            }
            mx = fmaxf(mx, __shfl_xor(mx, 16)); mx = fmaxf(mx, __shfl_xor(mx, 32));
            float sum = 0.f;
#pragma unroll
            for (int nl = 0; nl < 10; ++nl)
#pragma unroll
                for (int r = 0; r < 4; ++r) { const float p = __builtin_amdgcn_exp2f(s[nl][r] - mx); s[nl][r] = p; sum += p; }
            sum += __shfl_xor(sum, 16); sum += __shfl_xor(sum, 32);
            sum += __builtin_amdgcn_exp2f(sk - mx);
            const float inv = 1.f / sum;
            bf16x8 pb[5];
#pragma unroll
            for (int kk = 0; kk < 5; ++kk) pb[kk] = frag_from(s[2 * kk], s[2 * kk + 1]);
#pragma unroll
            for (int dt = 0; dt < 4; ++dt) {
                f32x4 o = (f32x4){0.f, 0.f, 0.f, 0.f};
#pragma unroll
                for (int kk = 0; kk < 5; ++kk) { const LAS unsigned char* vp = L + AT_VT + (16 * dt + fr) * AT_VT_LD + (16 * (mt + 2 * kk) + 4 * fq) * 2;
                    const v2u lo = *(const LAS v2u*)vp, hi = *(const LAS v2u*)(vp + 32); v4u av; av.x = lo.x; av.y = lo.y; av.z = hi.x; av.w = hi.y;
                    o = mfma16(__builtin_bit_cast(bf16x8, av), pb[kk], o); }
                v2u ov; ov.x = pk2(o[0] * inv, o[1] * inv); ov.y = pk2(o[2] * inv, o[3] * inv);
                *(GAS v2u*)(OB + (size_t)(b * T + t0 + 16 * mt + fr) * 1024 + h * 64 + 16 * dt + 4 * fq) = ov;
            }
        }
        WG_BAR_LDS();
    }
}
constexpr int N_PHASES = 18;
#ifndef MK_CUTS
#define MK_CUTS {0, N_PHASES}
#endif
__global__ void __launch_bounds__(NWAVES * 64, 2) hyb_fwd(Args args) {
    extern __shared__ __attribute__((aligned(16))) unsigned char lds[];
    Frame F;
    F.lds = (LAS unsigned char*)lds; F.MISC = (volatile LAS unsigned*)(F.lds + LDSCTL_OFF);
    F.tid = threadIdx.x; F.lane = F.tid & 63; F.wave = __builtin_amdgcn_readfirstlane(F.tid >> 6);
    F.G = gridDim.x; { const int bx = blockIdx.x; F.vcu = (F.G % 8 == 0) ? (bx % 8) * (F.G / 8) + bx / 8 : bx; }
    F.ws = args.ws; F.ctl = (gu32*)(args.ws + WS_CTL);
    for (int u = F.tid; u < 128; u += NWAVES * 64) ((LAS unsigned*)(F.lds + LDSCTL_OFF))[u] = 0u;
    __syncthreads();
    XcdBarrier bar = xcd_barrier_post((unsigned*)(F.ctl + CW_BAR) + args.li * XCD_BAR_WORDS, F.MISC + 8);
    const int lo = args.ph_lo, hi = args.ph_hi;
#ifndef PHMASK
#define PHMASK 0x3ffff
#endif
#define IN(k) ((((PHMASK) >> (k)) & 1) && lo <= (k) && (k) < hi)
#define SEAM(k) do { if (IN(k) && IN((k) + 1)) xcd_barrier(bar); } while (0)
#ifndef DUP_PHASE
#define DUP_PHASE -1
#endif
#define DUP(k) (DUP_PHASE == (k))
    LAS unsigned char* ring = F.lds;
    const int bx = (int)blockIdx.x;

#define RUN(k, ...) do { if (IN(k)) { __VA_ARGS__ } if (DUP(k) && IN(k)) { xcd_barrier(bar); __VA_ARGS__ } SEAM(k); } while (0)
    RUN(0, p0_prologue(F, args); );
    RUN(1,
        pg8::Gemm g{(const bf16*)args.out, (const bf16*)(F.ws + WS_W0T), M, 3072, D}; pg8::StaticOrder S; S.init(M, 3072, F.G, bx);
        pg8::EpiBf16<0> E{actp<bf16>(F, A_QK), D, nullptr, D, (size_t)M * D, 1.f};
        pg8::gemm_phase<pg8::EpiBf16<0>, pg8::StaticOrder, true, true>(ring, g, S, E); );
    RUN(2, cl_phase(F, args); );
#ifdef SPLIT_CONV
    if (IN(3)) { moe_weight_copies(F, args, bx * NWAVES + F.wave, F.G * NWAVES); xcd_barrier(bar);
#ifdef DUP_CONV
        moe_weight_copies(F, args, bx * NWAVES + F.wave, F.G * NWAVES); xcd_barrier(bar);
#endif
        if (bx < 32) scan_phase(F, bx, args.out);
#ifdef DUP_SCAN
        xcd_barrier(bar); if (bx < 32) scan_phase(F, bx, args.out);
#endif
    }
    SEAM(3);
#else
    RUN(3, if (bx < 32) scan_phase(F, bx, args.out);
           else moe_weight_copies(F, args, (bx - 32) * NWAVES + F.wave, (F.G - 32) * NWAVES); );
#endif
    RUN(4, gdn_out_phase(F, args); );
    RUN(5,
        pg8::Gemm g{actp<bf16>(F, A_OG), (const bf16*)(F.ws + WS_WO0T), M, D, D}; pg8::StaticOrder S; S.init(M, D, F.G, bx);
        pg8::EpiResF32 E{actp<float>(F, A_H), args.in[0], D, ALPHA};
        pg8::gemm_phase<pg8::EpiResF32, pg8::StaticOrder, true, true>(ring, g, S, E); );
    RUN(6, ln_phase(F, actp<float>(F, A_H), args.in[19], args.in[20], actp<float>(F, A_X), actp<bf16>(F, A_XB)); );
    RUN(7,
        pg8::Gemm g{actp<bf16>(F, A_XB), (const bf16*)(F.ws + WS_WGU0T), M, 2 * FF, D}; pg8::StaticOrder S; S.init(M, 2 * FF, F.G, bx);
        pg8::EpiSwiglu E{actp<bf16>(F, A_HACT), FF, 1 << 20, 0};
        pg8::gemm_phase<pg8::EpiSwiglu, pg8::StaticOrder, true, true>(ring, g, S, E); );
    RUN(8,
        pg8::Gemm g{actp<bf16>(F, A_HACT), (const bf16*)(F.ws + WS_WD0T), M, D, FF}; pg8::StaticOrder S; S.init(M, D, F.G, bx);
        pg8::EpiResF32 E{actp<float>(F, A_H), actp<float>(F, A_X), D, ALPHA};
        pg8::gemm_phase<pg8::EpiResF32, pg8::StaticOrder, true, true>(ring, g, S, E); );
    RUN(9, ln_phase(F, actp<float>(F, A_H), args.in[19] + D, args.in[20] + D, actp<float>(F, A_X), actp<bf16>(F, A_XB)); );
    RUN(10,
        pg8::Gemm g{actp<bf16>(F, A_XB), (const bf16*)(F.ws + WS_W1T), M, 1280, D}; pg8::StaticOrder S; S.init(M, 1280, F.G, bx);
        pg8::EpiQKV1 E{actp<bf16>(F, A_Q1), actp<bf16>(F, A_K1), actp<bf16>(F, A_V1), args.in[8], 0.125f * LOG2E};
        pg8::gemm_phase<pg8::EpiQKV1, pg8::StaticOrder, true, true>(ring, g, S, E); );
    RUN(11, attn_phase(F, args); );
    RUN(12,
        pg8::Gemm g{actp<bf16>(F, A_OB), (const bf16*)(F.ws + WS_WO1T), M, D, D}; pg8::StaticOrder S; S.init(M, D, F.G, bx);
        pg8::EpiResF32 E{args.out, actp<float>(F, A_X), D, ALPHA};
        pg8::gemm_phase<pg8::EpiResF32, pg8::StaticOrder, true, true>(ring, g, S, E); );
    RUN(13, ln3_router_phase(F, args); );
    RUN(14, gather_phase(F); );
#define MOE_SEG pg8::HSeg{F.ws + WS_ACT + A_HSEG_A, (unsigned char*)args.out, F.ws + 1 * MiB, HSEG_A_T, HSEG_B_T, HTILE}
    RUN(15, { LAS int* off = (LAS int*)(F.lds + AUX_OFF); LAS int* tile_e = off + 16; moe_offsets(F, off, tile_e); const int nT = off[8] >> 8;
        pg8::Gemm g{actp<bf16>(F, A_XG), (const bf16*)(F.ws + WS_WGUT), 0, 0, D}; MoeOrder S; S.init(0, nT, 28, F.G, bx, tile_e); S.segmented = false; S.seg = MOE_SEG;
        pg8::EpiSwigluSeg E{MOE_SEG, ED, 28};
        pg8::gemm_phase<pg8::EpiSwigluSeg, MoeOrder, true, true>(ring, g, S, E); } );
    RUN(16, { LAS int* off = (LAS int*)(F.lds + AUX_OFF); LAS int* tile_e = off + 16; moe_offsets(F, off, tile_e); const int nT = off[8] >> 8;
        pg8::Gemm g{nullptr, (const bf16*)(F.ws + WS_WDT), 0, 0, ED}; MoeOrder S; S.init(0, nT, 4, F.G, bx, tile_e); S.segmented = true; S.seg = MOE_SEG;
        pg8::EpiMoeOut E{actp<bf16>(F, A_Y), D, 4, 0};
        pg8::gemm_phase<pg8::EpiMoeOut, MoeOrder, true, true>(ring, g, S, E); } );
    RUN(17, final_phase(F, args); );
#undef IN
#undef SEAM
}

extern "C" void kernel_launch(void* const* d_in, const int* in_sizes, int n_in, void* d_out, int out_size, void* d_ws, size_t ws_size, hipStream_t stream) {
    static int grid = 0;
    if (grid == 0) {
        if (n_in != 21 || out_size != M * D || ws_size < WS_END) { fprintf(stderr, "kernel_launch: unexpected shapes (n_in %d, out %d, ws %zu)\n", n_in, out_size, ws_size); grid = -1; return; }
        int dev = 0, cus = 0, per_cu = 0;
        if (hipGetDevice(&dev) != hipSuccess || hipDeviceGetAttribute(&cus, hipDeviceAttributeMultiprocessorCount, dev) != hipSuccess) { grid = -1; return; }
        if (hipFuncSetAttribute((const void*)hyb_fwd, hipFuncAttributeMaxDynamicSharedMemorySize, LDS_BYTES) != hipSuccess) { fprintf(stderr, "kernel_launch: hipFuncSetAttribute failed\n"); grid = -1; return; }
        if (hipOccupancyMaxActiveBlocksPerMultiprocessor(&per_cu, (const void*)hyb_fwd, NWAVES * 64, LDS_BYTES) != hipSuccess || per_cu < 1) fprintf(stderr, "kernel_launch: occupancy query reports %d\n", per_cu);
        (void)hipGetLastError();
        grid = cus;
    }
    if (grid < 0) return;
    (void)hipMemsetAsync((char*)d_ws + WS_CTL, 0, CTL_ZERO_BYTES, stream);
    Args a{};
    for (int i = 0; i < 21; ++i) a.in[i] = (const float*)d_in[i];
    a.out = (float*)d_out; a.ws = (unsigned char*)d_ws; a.dbg = 0;
    const int cuts[] = MK_CUTS; const int ncut = (int)(sizeof(cuts) / sizeof(cuts[0]));
    for (int li = 0; li + 1 < ncut; ++li) {
        a.ph_lo = cuts[li]; a.ph_hi = cuts[li + 1]; a.li = li;
        hipLaunchKernelGGL(hyb_fwd, dim3(grid), dim3(NWAVES * 64), LDS_BYTES, stream, a);
    }
}
```
